# Optimizing an MI355X kernel written in HIP

```python
import math
import jax, jax.numpy as jnp
from jax import lax
import numpy as np

D_MODEL = 1024
BATCH = 2
SEQ = 8192
DEPTH = 2

GRID_W = 64
CTX_LEN = 256
D_FF = 2816
N_MOD = 9
LN_EPS = 1e-5
S5_WIDTH = 512
S5_GROUP = 16
S5_GROUPS = S5_WIDTH // S5_GROUP
S5_STATE = 64
S5_DT_MIN = 0.001
S5_DT_MAX = 0.1
NA_HEADS = 8
NA_HEAD_DIM = 64
NA_WIDTH = NA_HEADS * NA_HEAD_DIM
WIN_H = 8
WIN_W = 16
CONV_WIDTH = 512
CONV_K = 3
N_BRANCH = 3
BRANCH_WIDTH = 512
COL_U = 0
COL_K = COL_U + S5_WIDTH
COL_V = COL_K + NA_WIDTH
COL_Q = COL_V + NA_WIDTH
COL_Z = COL_Q + NA_WIDTH
COL_B = COL_Z + CONV_WIDTH
COL_C = COL_B + CONV_WIDTH
COL_G = COL_C + CONV_WIDTH
D_IN = COL_G + N_BRANCH * D_MODEL

kernel_name = 'hybrid_s5_natten_shortconv_macaron_trunk'


def layer_norm(x, g, b):
    xf = x.astype(jnp.float32)
    mu = jnp.mean(xf, -1, keepdims=True)
    var = jnp.mean(jnp.square(xf - mu), -1, keepdims=True)
    y = (xf - mu) * lax.rsqrt(var + LN_EPS) * g.astype(jnp.float32) + b.astype(jnp.float32)
    return y.astype(x.dtype)


def modulate(x, shift, scale):
    return x * (1.0 + scale) + shift


def swiglu(h, wg, wu, wd):
    return (jax.nn.silu(h @ wg) * (h @ wu)) @ wd


def ffn_sublayer(x, shift, scale, gate, wg, wu, wd, g, b, alpha):
    h = modulate(x, shift, scale)
    return layer_norm(alpha * x + 0.5 * gate * swiglu(h, wg, wu, wd), g, b)


def split_heads(t):
    return t.reshape(t.shape[:-1] + (NA_HEADS, NA_HEAD_DIM))


def s5_discretise(lam_re, lam_im, log_dt, b_re, b_im, c_re, c_im):
    f32 = jnp.float32
    lam = lax.complex(lam_re.astype(f32), lam_im.astype(f32))
    dt = jnp.exp(log_dt.astype(f32))[..., None]
    lam_bar = jnp.exp(lam * dt)
    b = lax.complex(b_re.astype(f32), b_im.astype(f32))
    b_bar = ((lam_bar - 1.0) / lam)[..., None] * b
    cc = lax.complex(c_re.astype(f32), c_im.astype(f32))
    return lam_bar, b_bar, cc


def _recurrence_combine(e1, e2):
    a1, b1 = e1
    a2, b2 = e2
    return a1 * a2, a2 * b1 + b2


def s5_scan(ug, lam_bar, b_bar, s0, reverse):
    t_len = ug.shape[1]
    if reverse:
        ug = jnp.flip(ug, 1)
    bu = jnp.einsum('gph,btgh->btgp', b_bar, ug.astype(jnp.float32).astype(jnp.complex64))
    bu = bu.at[:, 0].add(lam_bar * s0)
    a = jnp.broadcast_to(lam_bar, (1, t_len) + lam_bar.shape)
    _, states = lax.associative_scan(_recurrence_combine, (a, bu), axis=1)
    if reverse:
        states = jnp.flip(states, 1)
    return states


def s5_states(u, lam_bar, b_bar, s0_fwd, s0_bwd):
    bsz, t_len, _ = u.shape
    ug = u.reshape(bsz, t_len, S5_GROUPS, S5_GROUP)
    s_fwd = s5_scan(ug, lam_bar[0], b_bar[0], s0_fwd, False)
    s_bwd = s5_scan(ug, lam_bar[1], b_bar[1], s0_bwd, True)
    return s_fwd, s_bwd


def s5_readout(u, s_fwd, s_bwd, cc, d, w_glu):
    bsz, t_len, _ = u.shape
    y = jnp.real(jnp.einsum('ghp,btgp->btgh', cc[0], s_fwd) + jnp.einsum('ghp,btgp->btgh', cc[1], s_bwd))
    y = y.reshape(bsz, t_len, S5_WIDTH).astype(u.dtype) + d * u
    g = jax.nn.gelu(y)
    return g * jax.nn.sigmoid(g @ w_glu)


def neighbourhood_attention(q, k, v, k_ctx, v_ctx, rpb):
    bsz, s_len, n_h, dh = q.shape
    rows = s_len // GRID_W
    kh = min(WIN_H, rows)
    r = jnp.arange(rows)
    row_start = jnp.clip(r - WIN_H // 2, 0, rows - kh)
    row_idx = row_start[:, None] + jnp.arange(kh)[None, :]
    col = jnp.arange(GRID_W)
    col_start = jnp.clip(col - WIN_W // 2, 0, GRID_W - WIN_W)
    col_mask = (col[None, :] >= col_start[:, None]) & (col[None, :] < col_start[:, None] + WIN_W)
    dr = row_idx - r[:, None] + WIN_H - 1
    dc = jnp.clip(col[None, :] - col[:, None] + WIN_W - 1, 0, 2 * WIN_W - 2)
    bias = rpb.astype(jnp.float32)[:, dr]
    bias = jnp.transpose(bias[..., dc], (0, 1, 3, 2, 4))
    scale = dh ** -0.5
    qg = q.reshape(bsz, rows, GRID_W, n_h, dh)
    kg = k.reshape(bsz, rows, GRID_W, n_h, dh)[:, row_idx]
    vg = v.reshape(bsz, rows, GRID_W, n_h, dh)[:, row_idx].reshape(bsz, rows, kh * GRID_W, n_h, dh)
    s_win = jnp.einsum('brchd,brjkhd->bhrcjk', qg, kg).astype(jnp.float32) * scale + bias[None]
    s_win = jnp.where(col_mask[:, None, :], s_win, -jnp.inf).reshape(bsz, n_h, rows, GRID_W, kh * GRID_W)
    s_ctx = jnp.einsum('brchd,blhd->bhrcl', qg, k_ctx).astype(jnp.float32) * scale
    p = jax.nn.softmax(jnp.concatenate([s_win, s_ctx], axis=-1), axis=-1).astype(v.dtype)
    n_win = kh * GRID_W
    out = (jnp.einsum('bhrcn,brnhd->brchd', p[..., :n_win], vg)
           + jnp.einsum('bhrcl,blhd->brchd', p[..., n_win:], v_ctx))
    return out.reshape(bsz, s_len, n_h * dh)


def context_attention(q, k, v):
    bsz, l_len, n_h, dh = q.shape
    s = jnp.einsum('blhd,bmhd->bhlm', q, k).astype(jnp.float32) * dh ** -0.5
    p = jax.nn.softmax(s, axis=-1).astype(v.dtype)
    return jnp.einsum('bhlm,bmhd->blhd', p, v).reshape(bsz, l_len, n_h * dh)


def short_conv(z, bg, cg, conv_w):
    vv = cg * z
    t_len = vv.shape[1]
    pad = CONV_K // 2
    vp = jnp.pad(vv, ((0, 0), (pad, pad), (0, 0)))
    y = conv_w[0] * vp[:, 0:t_len]
    for i in range(1, CONV_K):
        y = y + conv_w[i] * vp[:, i:i + t_len]
    return bg * y


def merge_branches(gate_logits, y_a, y_b, y_c, w_branch, w_out):
    g = jax.nn.sigmoid(gate_logits).reshape(gate_logits.shape[:-1] + (N_BRANCH, D_MODEL))
    m = (g[..., 0, :] * (y_a @ w_branch[0]) + g[..., 1, :] * (y_b @ w_branch[1])
         + g[..., 2, :] * (y_c @ w_branch[2]))
    return m @ w_out


def setup_inputs(seed: int = 0) -> dict:
    key = jax.random.key(seed)
    ks = jax.random.split(key, 26)
    f32 = jnp.float32
    beta = (8.0 * DEPTH) ** -0.25

    def nrm(k, shape, s):
        return jax.random.normal(k, shape, f32) * s

    G, P, Hg = S5_GROUPS, S5_STATE, S5_GROUP
    n = jnp.arange(S5_STATE, dtype=f32)
    return {
        'x': nrm(ks[0], (BATCH, SEQ, D_MODEL), 1.0),
        'c': nrm(ks[1], (BATCH, D_MODEL), 1.0),
        'ctx': nrm(ks[2], (BATCH, CTX_LEN, D_MODEL), 1.0),
        'c_ctx': nrm(ks[3], (D_MODEL,), 1.0),
        'w_mod': nrm(ks[4], (DEPTH, D_MODEL, N_MOD * D_MODEL), 0.5 * D_MODEL ** -0.5),
        'b_mod': nrm(ks[5], (DEPTH, N_MOD * D_MODEL), 0.01),
        'ln_g': 1.0 + nrm(ks[6], (DEPTH, 3, D_MODEL), 0.02),
        'ln_b': nrm(ks[7], (DEPTH, 3, D_MODEL), 0.02),
        'ffn_wg': nrm(ks[8], (DEPTH, 2, D_MODEL, D_FF), D_MODEL ** -0.5),
        'ffn_wu': nrm(ks[9], (DEPTH, 2, D_MODEL, D_FF), D_MODEL ** -0.5),
        'ffn_wd': nrm(ks[10], (DEPTH, 2, D_FF, D_MODEL), beta * D_FF ** -0.5),
        'w_in': nrm(ks[11], (DEPTH, D_MODEL, D_IN), D_MODEL ** -0.5),
        's5_lam_re': -0.5 + nrm(ks[12], (DEPTH, 2, G, P), 0.01),
        's5_lam_im': math.pi * n + nrm(ks[13], (DEPTH, 2, G, P), 0.01),
        's5_log_dt': jax.random.uniform(ks[14], (DEPTH, 2, G), f32, math.log(S5_DT_MIN), math.log(S5_DT_MAX)),
        's5_b_re': nrm(ks[15], (DEPTH, 2, G, P, Hg), (2.0 * Hg) ** -0.5),
        's5_b_im': nrm(ks[16], (DEPTH, 2, G, P, Hg), (2.0 * Hg) ** -0.5),
        's5_c_re': nrm(ks[17], (DEPTH, 2, G, Hg, P), (2.0 * P) ** -0.5),
        's5_c_im': nrm(ks[18], (DEPTH, 2, G, Hg, P), (2.0 * P) ** -0.5),
        's5_d': nrm(ks[19], (DEPTH, S5_WIDTH), 1.0),
        's5_w_glu': nrm(ks[20], (DEPTH, S5_WIDTH, S5_WIDTH), S5_WIDTH ** -0.5),
        'na_rpb': nrm(ks[21], (DEPTH, NA_HEADS, 2 * WIN_H - 1, 2 * WIN_W - 1), 0.1),
        'conv_w': nrm(ks[22], (DEPTH, CONV_K, CONV_WIDTH), CONV_K ** -0.5),
        'w_branch': nrm(ks[23], (DEPTH, N_BRANCH, BRANCH_WIDTH, D_MODEL), BRANCH_WIDTH ** -0.5),
        'w_out': nrm(ks[24], (DEPTH, D_MODEL, D_MODEL), beta * D_MODEL ** -0.5),
    }


def reference(x, c, ctx, c_ctx, w_mod, b_mod, ln_g, ln_b, ffn_wg, ffn_wu, ffn_wd, w_in,
              s5_lam_re, s5_lam_im, s5_log_dt, s5_b_re, s5_b_im, s5_c_re, s5_c_im, s5_d, s5_w_glu,
              na_rpb, conv_w, w_branch, w_out):
    bsz = x.shape[0]
    alpha = (2.0 * DEPTH) ** 0.25
    silu_c = jax.nn.silu(c)[:, None, :]
    silu_cc = jax.nn.silu(c_ctx)
    xc = ctx
    for l in range(DEPTH):
        last = l == DEPTH - 1
        mod = (silu_c @ w_mod[l] + b_mod[l]).reshape(bsz, 1, N_MOD, D_MODEL)
        mod = [mod[:, :, i] for i in range(N_MOD)]
        modc = (silu_cc @ w_mod[l] + b_mod[l]).reshape(N_MOD, D_MODEL)

        x = ffn_sublayer(x, mod[0], mod[1], mod[2], ffn_wg[l, 0], ffn_wu[l, 0], ffn_wd[l, 0],
                         ln_g[l, 0], ln_b[l, 0], alpha)
        xc = ffn_sublayer(xc, modc[0], modc[1], modc[2], ffn_wg[l, 0], ffn_wu[l, 0], ffn_wd[l, 0],
                          ln_g[l, 0], ln_b[l, 0], alpha)

        lam_bar, b_bar, cc = s5_discretise(s5_lam_re[l], s5_lam_im[l], s5_log_dt[l],
                                           s5_b_re[l], s5_b_im[l], s5_c_re[l], s5_c_im[l])
        h = modulate(x, mod[3], mod[4])
        hc = modulate(xc, modc[3], modc[4])

        proj_c = hc @ (w_in[l][:, :COL_Q] if last else w_in[l])
        u_c = proj_c[..., COL_U:COL_K]
        k_c = split_heads(proj_c[..., COL_K:COL_V])
        v_c = split_heads(proj_c[..., COL_V:COL_Q])
        zero_state = jnp.zeros((bsz, S5_GROUPS, S5_STATE), jnp.complex64)
        sf_c, sb_c = s5_states(u_c, lam_bar, b_bar, zero_state, zero_state)

        proj = h @ w_in[l]
        u = proj[..., COL_U:COL_K]
        sf, sb = s5_states(u, lam_bar, b_bar, sf_c[:, -1], sb_c[:, 0])
        y_a = s5_readout(u, sf, sb, cc, s5_d[l], s5_w_glu[l])
        y_b = neighbourhood_attention(split_heads(proj[..., COL_Q:COL_Z]), split_heads(proj[..., COL_K:COL_V]),
                                      split_heads(proj[..., COL_V:COL_Q]), k_c, v_c, na_rpb[l])
        y_c = short_conv(proj[..., COL_Z:COL_B], proj[..., COL_B:COL_C], proj[..., COL_C:COL_G], conv_w[l])
        mix = merge_branches(proj[..., COL_G:], y_a, y_b, y_c, w_branch[l], w_out[l])
        x = layer_norm(alpha * x + mod[5] * mix, ln_g[l, 1], ln_b[l, 1])

        x = ffn_sublayer(x, mod[6], mod[7], mod[8], ffn_wg[l, 1], ffn_wu[l, 1], ffn_wd[l, 1],
                         ln_g[l, 2], ln_b[l, 2], alpha)

        if not last:
            yc_a = s5_readout(u_c, sf_c, sb_c, cc, s5_d[l], s5_w_glu[l])
            yc_b = context_attention(split_heads(proj_c[..., COL_Q:COL_Z]), k_c, v_c)
            yc_c = short_conv(proj_c[..., COL_Z:COL_B], proj_c[..., COL_B:COL_C], proj_c[..., COL_C:COL_G], conv_w[l])
            mix_c = merge_branches(proj_c[..., COL_G:], yc_a, yc_b, yc_c, w_branch[l], w_out[l])
            xc = layer_norm(alpha * xc + modc[5] * mix_c, ln_g[l, 1], ln_b[l, 1])
            xc = ffn_sublayer(xc, modc[6], modc[7], modc[8], ffn_wg[l, 1], ffn_wu[l, 1], ffn_wd[l, 1],
                              ln_g[l, 2], ln_b[l, 2], alpha)
    return x
```

```cpp
#include <hip/hip_runtime.h>
#include <hip/hip_cooperative_groups.h>
#include <cstdio>
#include <cstdint>
namespace cg = cooperative_groups;

namespace pg8 {
#define PG8_LAS __attribute__((address_space(3)))
typedef unsigned short bf16_t;
typedef short bf16x8 __attribute__((ext_vector_type(8)));
typedef float f32x4 __attribute__((ext_vector_type(4)));
typedef unsigned u32x4 __attribute__((ext_vector_type(4)));
constexpr int BM = 256, BK = 64, HALF = 128, HTB = HALF * BK * 2  , STAGE_BYTES = 8 * HTB, NXCD = 8, WGM = 8;

__host__ __device__ __forceinline__ int lds_byte(int r, int c) { const int st = (r >> 4) * 2 + (c >> 5), rr = r & 15, cc = c & 31, ob = rr * 64 + cc * 2; return st * 1024 + (ob ^ (((ob >> 9) & 1) << 5)); }
__host__ __device__ __forceinline__ void stage_rc(int b, int& R, int& C) { const int st = b / 1024, sb = b % 1024, swz = sb ^ (((sb >> 9) & 1) << 5); R = (st >> 1) * 16 + swz / 64; C = (st & 1) * 32 + (swz % 64) / 2; }
__host__ __device__ __forceinline__ int perm32(int rho) { const int n = rho >> 4, i = rho & 15; return 8 * (i >> 2) + 4 * n + (i & 3); }

struct Unit { int pm, pn; };
struct Gemm { const bf16_t* A; const bf16_t* Bt; int M, N, K; };

struct StaticOrder {
    int nM, nN, nwg, G, c;
    __host__ __device__ void init(int M, int N, int G_, int c_) { nM = M / BM; nN = N / BM; nwg = nM * nN; G = G_; c = c_; }
    __host__ __device__ bool next(int i, Unit& u) const {
        const long L = (long)i * G + c; if (L >= nwg) return false;
        int wgid = (int)L; { const int q = nwg / NXCD, r = nwg % NXCD, xcd = wgid % NXCD, off = wgid / NXCD; wgid = (xcd < r ? xcd * (q + 1) : r * (q + 1) + (xcd - r) * q) + off; }
        const int nig = WGM * nN, gid = wgid / nig, fm = gid * WGM, gsz = (nM - fm) < WGM ? (nM - fm) : WGM;
        u.pm = fm + ((wgid % nig) % gsz); u.pn = (wgid % nig) / gsz; return true;
    }
    __device__ __forceinline__ void a_ready(const Unit&) const {}
    __device__ __forceinline__ void done(const Unit&) const {}
};
typedef float f32x2_cv __attribute__((ext_vector_type(2))); typedef __bf16 bf16x2_cv __attribute__((ext_vector_type(2)));
__device__ __forceinline__ unsigned cvt_pk_bf16(float lo, float hi) { f32x2_cv v = {lo, hi}; bf16x2_cv b = __builtin_convertvector(v, bf16x2_cv); return __builtin_bit_cast(unsigned, b); }
template <class Epi, class Sched, bool ALIGN_EPI = false, bool SP2 = false>
__device__ __forceinline__ void gemm_phase(PG8_LAS unsigned char* lds, const Gemm g, const Sched& S, const Epi& E) {
    int tid_ = threadIdx.x; asm volatile("" : "+v"(tid_));
    const int tid = tid_, wid = __builtin_amdgcn_readfirstlane(tid >> 6), lane = tid & 63, wr = wid >> 2, wc = wid & 3, fr = lane & 15, fq = lane >> 4;
    const int K = g.K, nt = K / BK;
    unsigned voffA[2], voffB[2];
#pragma unroll
    for (int i = 0; i < 2; ++i) { int R, C; stage_rc(tid * 16 + i * 8192, R, C); const int Rb = Epi::PERM ? ((R & ~31) + perm32(R & 31)) : R;
        voffA[i] = (unsigned)(R * K + C) * 2u; voffB[i] = (unsigned)(Rb * K + C) * 2u; }
    const size_t kstep = (size_t)(BK * 2);
    const size_t hstep = (size_t)HALF * K * 2;
    const size_t tstep = 2 * hstep;
    const unsigned ldsw = (unsigned)wid * 1024u;
    const int aoff = lds_byte(wr * 64 + fr, fq * 8), boff = lds_byte(wc * 32 + fr, fq * 8);
#define PG8_SA(b, h) (((b) * 2 + (h)) * HTB)
#define PG8_SB(b, h) ((4 + (b) * 2 + (h)) * HTB)
#define PG8_STAGE(bufoff, gbase, voff) do { _Pragma("unroll") for (int _i = 0; _i < 2; ++_i) \
        __builtin_amdgcn_global_load_lds((const unsigned*)((const char*)(gbase) + (voff)[_i]), (PG8_LAS unsigned*)(lds + (bufoff) + ldsw + _i * 8192), 16, 0, 0); } while (0)
#define PG8_LDA(dst, b, h) do { _Pragma("unroll") for (int m = 0; m < 4; ++m) _Pragma("unroll") for (int k = 0; k < 2; ++k) dst[m][k] = *(const PG8_LAS bf16x8*)(lds + PG8_SA(b, h) + aoff + m * 2048 + k * 1024); } while (0)
#define PG8_LDB(dst, b, h) do { _Pragma("unroll") for (int n = 0; n < 2; ++n) _Pragma("unroll") for (int k = 0; k < 2; ++k) dst[n][k] = *(const PG8_LAS bf16x8*)(lds + PG8_SB(b, h) + boff + n * 2048 + k * 1024); } while (0)
#define PG8_MMA(ai, bj, At, Bt) do { __builtin_amdgcn_s_setprio(1); _Pragma("unroll") for (int m = 0; m < 4; ++m) _Pragma("unroll") for (int n = 0; n < 2; ++n) _Pragma("unroll") for (int k = 0; k < 2; ++k) \
        acc[ai][bj][m][n] = __builtin_amdgcn_mfma_f32_16x16x32_bf16(Bt[n][k], At[m][k], acc[ai][bj][m][n], 0, 0, 0); __builtin_amdgcn_s_setprio(0); } while (0)
#define PG8_WAIT_V(n) asm volatile("s_waitcnt vmcnt(" #n ")" ::: "memory")
#define PG8_WAIT_L(n) asm volatile("s_waitcnt lgkmcnt(" #n ")" ::: "memory")
#define PG8_BAR __builtin_amdgcn_s_barrier()
#define PG8_SCHED __builtin_amdgcn_sched_barrier(0)
    Unit cur, nxt; int ui = 0;
    if (!S.next(0, cur)) return;
    f32x4 acc[2][2][4][2];
#pragma unroll
    for (int a = 0; a < 2; ++a)
#pragma unroll
        for (int b = 0; b < 2; ++b)
#pragma unroll
            for (int m = 0; m < 4; ++m)
#pragma unroll
                for (int n = 0; n < 2; ++n) acc[a][b][m][n] = (f32x4){0.f, 0.f, 0.f, 0.f};
    bf16x8 At[4][2], B0[2][2], B1[2][2];
    const char* cA = (const char*)g.A + (size_t)cur.pm * tstep; const char* cB = (const char*)g.Bt + (size_t)cur.pn * tstep;
    S.a_ready(cur);
    if constexpr (SP2) {
        PG8_STAGE(PG8_SB(0, 0), cB, voffB); PG8_STAGE(PG8_SB(0, 1), cB + hstep, voffB); PG8_STAGE(PG8_SA(0, 0), cA, voffA); PG8_STAGE(PG8_SA(0, 1), cA + hstep, voffA);
        if (wr == 1) PG8_BAR;
        PG8_WAIT_V(2); PG8_BAR;
        PG8_STAGE(PG8_SB(1, 0), cB + kstep, voffB); PG8_STAGE(PG8_SA(1, 0), cA + kstep, voffA); PG8_STAGE(PG8_SB(1, 1), cB + hstep + kstep, voffB);
        PG8_WAIT_V(6); PG8_BAR;
    } else {
        PG8_STAGE(PG8_SB(0, 0), cB, voffB); PG8_STAGE(PG8_SA(0, 0), cA, voffA); PG8_STAGE(PG8_SB(0, 1), cB + hstep, voffB); PG8_STAGE(PG8_SA(0, 1), cA + hstep, voffA);
        if (wr == 1) PG8_BAR;
        PG8_WAIT_V(4); PG8_BAR;
        PG8_STAGE(PG8_SB(1, 0), cB + kstep, voffB); PG8_STAGE(PG8_SA(1, 0), cA + kstep, voffA); PG8_STAGE(PG8_SB(1, 1), cB + hstep + kstep, voffB);
        PG8_WAIT_V(6); PG8_BAR;
    }
    for (;;) {
        const bool has_next = S.next(ui + 1, nxt);
        const char* nA = has_next ? (const char*)g.A + (size_t)nxt.pm * tstep : cA; const char* nB = has_next ? (const char*)g.Bt + (size_t)nxt.pn * tstep : cB;
        for (int t = 0; t < nt; t += 2) {
            const bool last = (t == nt - 2);
            const char* a1 = cA + (size_t)(t + 1) * kstep;
            const char* a2 = last ? nA : cA + (size_t)(t + 2) * kstep; const char* b2 = last ? nB : cB + (size_t)(t + 2) * kstep;
            const char* a3 = a2 + kstep; const char* b3 = b2 + kstep;
            if (last && has_next) S.a_ready(nxt);
            if constexpr (SP2) {
            PG8_LDB(B0, 0, 0); PG8_LDB(B1, 0, 1); PG8_SCHED; PG8_LDA(At, 0, 0); PG8_STAGE(PG8_SA(1, 1), a1 + hstep, voffA);
            PG8_WAIT_V(8); PG8_WAIT_L(0); PG8_BAR; PG8_MMA(0, 0, At, B0); PG8_MMA(0, 1, At, B1); PG8_BAR; PG8_SCHED;
            PG8_LDA(At, 0, 1); PG8_STAGE(PG8_SB(0, 0), b2, voffB); PG8_STAGE(PG8_SB(0, 1), b2 + hstep, voffB); PG8_STAGE(PG8_SA(0, 0), a2, voffA);
            PG8_WAIT_V(8); PG8_WAIT_L(0); PG8_BAR; PG8_MMA(1, 0, At, B0); PG8_MMA(1, 1, At, B1); PG8_BAR; PG8_SCHED;
            PG8_LDB(B0, 1, 0); PG8_LDB(B1, 1, 1); PG8_SCHED; PG8_LDA(At, 1, 0); PG8_STAGE(PG8_SA(0, 1), a2 + hstep, voffA);
            PG8_WAIT_V(8); PG8_WAIT_L(0); PG8_BAR; PG8_MMA(0, 0, At, B0); PG8_MMA(0, 1, At, B1); PG8_BAR; PG8_SCHED;
            PG8_LDA(At, 1, 1); PG8_STAGE(PG8_SB(1, 0), b3, voffB); PG8_STAGE(PG8_SB(1, 1), b3 + hstep, voffB); PG8_STAGE(PG8_SA(1, 0), a3, voffA);
            PG8_WAIT_V(8); PG8_WAIT_L(0); PG8_BAR; PG8_MMA(1, 0, At, B0); PG8_MMA(1, 1, At, B1); PG8_BAR; PG8_SCHED;
            } else {
            PG8_LDB(B0, 0, 0); PG8_SCHED; PG8_LDA(At, 0, 0); PG8_STAGE(PG8_SA(1, 1), a1 + hstep, voffA);
            PG8_WAIT_L(8); PG8_BAR; PG8_WAIT_L(0); PG8_MMA(0, 0, At, B0); PG8_BAR; PG8_SCHED;
            PG8_LDB(B1, 0, 1); PG8_STAGE(PG8_SB(0, 0), b2, voffB);
            PG8_BAR; PG8_WAIT_L(0); PG8_MMA(0, 1, At, B1); PG8_BAR;
            PG8_LDA(At, 0, 1); PG8_STAGE(PG8_SA(0, 0), a2, voffA);
            PG8_BAR; PG8_WAIT_L(0); PG8_MMA(1, 0, At, B0); PG8_BAR; PG8_SCHED;
            PG8_STAGE(PG8_SB(0, 1), b2 + hstep, voffB);
            PG8_WAIT_V(6); PG8_BAR; PG8_MMA(1, 1, At, B1); PG8_BAR;
            PG8_LDB(B0, 1, 0); PG8_SCHED; PG8_LDA(At, 1, 0); PG8_STAGE(PG8_SA(0, 1), a2 + hstep, voffA);
            PG8_WAIT_L(8); PG8_BAR; PG8_WAIT_L(0); PG8_MMA(0, 0, At, B0); PG8_BAR; PG8_SCHED;
            PG8_LDB(B1, 1, 1); PG8_STAGE(PG8_SB(1, 0), b3, voffB);
            PG8_BAR; PG8_WAIT_L(0); PG8_MMA(0, 1, At, B1); PG8_BAR;
            PG8_LDA(At, 1, 1); PG8_STAGE(PG8_SA(1, 0), a3, voffA);
            PG8_BAR; PG8_WAIT_L(0); PG8_MMA(1, 0, At, B0); PG8_BAR; PG8_SCHED;
            PG8_STAGE(PG8_SB(1, 1), b3 + hstep, voffB);
            PG8_WAIT_V(6); PG8_BAR; PG8_MMA(1, 1, At, B1); PG8_BAR;
            }
        }
        if constexpr (ALIGN_EPI) { if (wr == 0) PG8_BAR; }
        if constexpr (!Epi::AFTER_DRAIN) { E(acc, cur, wr, wc, fr, fq); S.done(cur); }
        if (!has_next) break;
#pragma unroll
        for (int a = 0; a < 2; ++a)
#pragma unroll
            for (int b = 0; b < 2; ++b)
#pragma unroll
                for (int m = 0; m < 4; ++m)
#pragma unroll
                    for (int n = 0; n < 2; ++n) acc[a][b][m][n] = (f32x4){0.f, 0.f, 0.f, 0.f};
        cur = nxt; cA = nA; cB = nB; ++ui;
        if constexpr (ALIGN_EPI) { if (wr == 1) PG8_BAR; }
    }
    PG8_WAIT_V(0);
    if constexpr (!ALIGN_EPI) { if (wr == 0) PG8_BAR; }
    PG8_BAR;
    if constexpr (Epi::AFTER_DRAIN) { E.fused(acc, cur, wr, wc, fr, fq, lds, wid, lane); S.done(cur); }
#undef PG8_SA
#undef PG8_SB
#undef PG8_STAGE
#undef PG8_LDA
#undef PG8_LDB
#undef PG8_MMA
#undef PG8_WAIT_V
#undef PG8_WAIT_L
#undef PG8_BAR
#undef PG8_SCHED
}
}

#define GAS __attribute__((address_space(1)))
#define LAS __attribute__((address_space(3)))
typedef unsigned short bf16;
typedef unsigned v4u __attribute__((ext_vector_type(4)));
typedef unsigned v2u __attribute__((ext_vector_type(2)));
typedef float f32x4 __attribute__((ext_vector_type(4)));
typedef float f32x16 __attribute__((ext_vector_type(16)));
typedef short bf16x8 __attribute__((ext_vector_type(8)));

constexpr int D = 1024, SEQ = 8192, CTXL = 256, RL = 16384, RC = 512, R = RL + RC, FF = 2816, NUP = 2 * FF;
constexpr int PJ = 3584;
constexpr int DIN = 6656, NGATE = 3072;
constexpr int COL_U = 0, COL_K = 512, COL_V = 1024, COL_Q = 1536, COL_Z = 2048, COL_B = 2560, COL_C = 3072;
constexpr int TOKP = SEQ + CTXL;
constexpr int NMODV = 9 * D;
constexpr float LN_EPS = 1e-5f;
constexpr float ALPHA = 1.4142135623730951f;
constexpr int NCH = 66;
constexpr int NWAVES = 8;

constexpr size_t KiB = 1024, MiB = 1024 * 1024;
constexpr size_t WS_MODV = 0, MODV_ZERO_BYTES = 256 * KiB;
constexpr size_t WS_LAM = 256 * KiB, WS_LAML = 320 * KiB;
constexpr size_t WS_PTRS = 384 * KiB;
constexpr size_t WS_BB = 1 * MiB;
constexpr size_t WS_CT = 2 * MiB;
constexpr size_t WS_E = 3 * MiB;
constexpr size_t WS_W = 8 * MiB;
constexpr size_t WB_UP = (size_t)NUP * D * 2, WB_DN = (size_t)D * FF * 2, WB_IN = (size_t)DIN * D * 2, WB_G = (size_t)(512 + 3072) * 512 * 2, WB_OUT = (size_t)D * D * 2;
constexpr size_t WO_UP0 = 0, WO_UP1 = WB_UP, WO_DN0 = 2 * WB_UP, WO_DN1 = WO_DN0 + WB_DN, WO_IN = WO_DN1 + WB_DN, WO_G = WO_IN + WB_IN, WO_OUT = WO_G + WB_G, WL_BYTES = WO_OUT + WB_OUT;
constexpr size_t WS_XC = WS_W + 2 * WL_BYTES;
constexpr size_t WS_A = WS_XC + (size_t)RC * D * 4;
constexpr size_t WS_Y3 = WS_A + (size_t)R * PJ * 2;
constexpr size_t WS_H = WS_Y3 + (size_t)3 * R * 512 * 2;
constexpr size_t WS_VT = WS_H + (size_t)R * D * 2;
constexpr size_t WS_END = WS_VT + (size_t)R * 512 * 2;
static_assert(WS_E + (size_t)2 * 32 * NCH * 2 * 64 * 2 * 4 <= WS_W, "E fits");
static_assert(WS_W % 256 == 0 && WL_BYTES % 256 == 0 && WS_A % 256 == 0 && WS_Y3 % 256 == 0 && WS_H % 256 == 0 && WS_VT % 256 == 0, "alignment");

constexpr int LDS_BYTES = 131072 + 16384;

__device__ __forceinline__ unsigned f2bf(float f) { unsigned u = __builtin_bit_cast(unsigned, f); return (u + 0x7fffu + ((u >> 16) & 1u)) >> 16; }
__device__ __forceinline__ unsigned pk2(float lo, float hi) { return pg8::cvt_pk_bf16(lo, hi); }
__device__ __forceinline__ float bf2f(unsigned short b) { return __builtin_bit_cast(float, (unsigned)b << 16); }
__device__ __forceinline__ float bflo(unsigned w) { return __builtin_bit_cast(float, w << 16); }
__device__ __forceinline__ float bfhi(unsigned w) { return __builtin_bit_cast(float, w & 0xffff0000u); }
__device__ __forceinline__ float sigmoidf_(float x) { return __builtin_amdgcn_rcpf(1.0f + __expf(-x)); }
__device__ __forceinline__ float siluf_(float x) { return x * sigmoidf_(x); }
__device__ __forceinline__ float gelu_tanh(float x) { const float u = 0.7978845608028654f * (x + 0.044715f * x * x * x); return x * sigmoidf_(2.0f * u); }
__device__ __forceinline__ float wave_sum(float v) {
#pragma unroll
    for (int o = 1; o < 64; o <<= 1) v += __shfl_xor(v, o);
    return v;
}
__device__ __forceinline__ int mid_of_row(int row) { return row < RL ? (row >> 13) : 2; }

using pg8::Unit;
struct EpiSwiglu {
    static constexpr bool PERM = true, AFTER_DRAIN = false;
    bf16* O;
    __device__ __forceinline__ void operator()(const f32x4 (&acc)[2][2][4][2], const Unit& u, int wr, int wc, int fr, int fq) const {
        const int row0 = u.pm * 256 + wr * 64 + fr, col0 = u.pn * 128 + wc * 32 + 8 * fq;
#pragma unroll
        for (int ai = 0; ai < 2; ++ai)
#pragma unroll
            for (int m = 0; m < 4; ++m) {
                bf16* rowp = O + (size_t)(row0 + ai * 128 + m * 16) * FF + col0;
                const f32x4 g0 = acc[ai][0][m][0], g1 = acc[ai][0][m][1], u0 = acc[ai][1][m][0], u1 = acc[ai][1][m][1];
                v4u w;
                w.x = pk2(siluf_(g0[0]) * u0[0], siluf_(g0[1]) * u0[1]); w.y = pk2(siluf_(g0[2]) * u0[2], siluf_(g0[3]) * u0[3]);
                w.z = pk2(siluf_(g1[0]) * u1[0], siluf_(g1[1]) * u1[1]); w.w = pk2(siluf_(g1[2]) * u1[2], siluf_(g1[3]) * u1[3]);
                *(v4u*)rowp = w;
            }
    }
};
struct EpiRes {
    static constexpr bool PERM = false, AFTER_DRAIN = false;
    const float* xin_lat; const float* xin_ctx; float* xout_lat; float* xout_ctx; const float* gate  ; float coef;
    __device__ __forceinline__ void operator()(const f32x4 (&acc)[2][2][4][2], const Unit& u, int wr, int wc, int fr, int fq) const {
        const bool lat = u.pm < 64;
        const float* xin = lat ? xin_lat + (size_t)u.pm * 256 * D : xin_ctx + (size_t)(u.pm - 64) * 256 * D;
        float* xout = lat ? xout_lat + (size_t)u.pm * 256 * D : xout_ctx + (size_t)(u.pm - 64) * 256 * D;
        const int mid = lat ? (u.pm >> 5) : 2;
        const int col0 = u.pn * 256 + wc * 32 + 4 * fq;
        const float* gp = gate + (size_t)mid * NMODV + col0;
#pragma unroll
        for (int bj = 0; bj < 2; ++bj)
#pragma unroll
            for (int n = 0; n < 2; ++n) {
                const f32x4 gv = *(const f32x4*)(gp + bj * 128 + n * 16) * coef;
#pragma unroll
                for (int ai = 0; ai < 2; ++ai)
#pragma unroll
                    for (int m = 0; m < 4; ++m) {
                        const size_t off = (size_t)(ai * 128 + wr * 64 + m * 16 + fr) * D + col0 + bj * 128 + n * 16;
                        const f32x4 xi = *(const f32x4*)(xin + off);
                        *(f32x4*)(xout + off) = xi * ALPHA + gv * acc[ai][bj][m][n];
                        asm volatile("" ::: "memory");
                    }
            }
    }
};
struct EpiProj {
    static constexpr bool PERM = true, AFTER_DRAIN = false;
    bf16* P; bf16* VT;
    __device__ __forceinline__ void operator()(const f32x4 (&acc)[2][2][4][2], const Unit& u, int wr, int wc, int fr, int fq) const {
        const int row0 = u.pm * 256 + wr * 64 + fr, col0 = u.pn * 256 + wc * 32 + 8 * fq;
        if (u.pn == 4 || u.pn == 5) {
#pragma unroll
            for (int ai = 0; ai < 2; ++ai)
#pragma unroll
                for (int m = 0; m < 4; ++m) {
                    const int row = row0 + ai * 128 + m * 16;
                    int b, tok; if (row < RL) { b = row >> 13; tok = row & 8191; } else { b = (row - RL) >> 8; tok = SEQ + ((row - RL) & 255); }
#pragma unroll
                    for (int bj = 0; bj < 2; ++bj)
#pragma unroll
                        for (int n = 0; n < 2; ++n)
#pragma unroll
                            for (int e = 0; e < 4; ++e) {
                                const int vc = col0 + bj * 128 + 4 * n + e - COL_V;
                                VT[((size_t)(b * 512 + vc)) * TOKP + tok] = (bf16)f2bf(acc[ai][bj][m][n][e]);
                            }
                }
        } else {
#pragma unroll
            for (int ai = 0; ai < 2; ++ai)
#pragma unroll
                for (int m = 0; m < 4; ++m) {
                    bf16* rowp = P + (size_t)(row0 + ai * 128 + m * 16) * PJ + col0;
#pragma unroll
                    for (int bj = 0; bj < 2; ++bj) {
                        const f32x4 v0 = acc[ai][bj][m][0], v1 = acc[ai][bj][m][1];
                        v4u w; w.x = pk2(v0[0], v0[1]); w.y = pk2(v0[2], v0[3]); w.z = pk2(v1[0], v1[1]); w.w = pk2(v1[2], v1[3]);
                        *(v4u*)(rowp + bj * 128) = w;
                    }
                }
        }
    }
};
struct EpiGates {
    static constexpr bool PERM = true, AFTER_DRAIN = false;
    bf16* P;
    __device__ __forceinline__ void operator()(const f32x4 (&acc)[2][2][4][2], const Unit& u, int wr, int wc, int fr, int fq) const {
        const int row0 = u.pm * 256 + wr * 64 + fr, col0 = 512 + u.pn * 256 + wc * 32 + 8 * fq;
#pragma unroll
        for (int ai = 0; ai < 2; ++ai)
#pragma unroll
            for (int m = 0; m < 4; ++m) {
                bf16* rowp = P + (size_t)(row0 + ai * 128 + m * 16) * PJ + col0;
#pragma unroll
                for (int bj = 0; bj < 2; ++bj) {
                    const f32x4 v0 = acc[ai][bj][m][0], v1 = acc[ai][bj][m][1];
                    v4u w; w.x = pk2(sigmoidf_(v0[0]), sigmoidf_(v0[1])); w.y = pk2(sigmoidf_(v0[2]), sigmoidf_(v0[3]));
                    w.z = pk2(sigmoidf_(v1[0]), sigmoidf_(v1[1])); w.w = pk2(sigmoidf_(v1[2]), sigmoidf_(v1[3]));
                    *(v4u*)(rowp + bj * 128) = w;
                }
            }
    }
};
struct EpiGlu {
    static constexpr bool PERM = true, AFTER_DRAIN = false;
    const bf16* GA; bf16* YA;
    __device__ __forceinline__ void operator()(const f32x4 (&acc)[2][2][4][2], const Unit& u, int wr, int wc, int fr, int fq) const {
        const int row0 = u.pm * 256 + wr * 64 + fr, col0 = u.pn * 256 + wc * 32 + 8 * fq;
#pragma unroll
        for (int ai = 0; ai < 2; ++ai)
#pragma unroll
            for (int m = 0; m < 4; ++m) {
                const size_t ro = (size_t)(row0 + ai * 128 + m * 16) * 512 + col0;
#pragma unroll
                for (int bj = 0; bj < 2; ++bj) {
                    const v4u gin = *(const v4u*)(GA + ro + bj * 128);
                    const f32x4 v0 = acc[ai][bj][m][0], v1 = acc[ai][bj][m][1];
                    v4u w;
                    w.x = pk2(bflo(gin.x) * sigmoidf_(v0[0]), bfhi(gin.x) * sigmoidf_(v0[1])); w.y = pk2(bflo(gin.y) * sigmoidf_(v0[2]), bfhi(gin.y) * sigmoidf_(v0[3]));
                    w.z = pk2(bflo(gin.z) * sigmoidf_(v1[0]), bfhi(gin.z) * sigmoidf_(v1[1])); w.w = pk2(bflo(gin.w) * sigmoidf_(v1[2]), bfhi(gin.w) * sigmoidf_(v1[3]));
                    *(v4u*)(YA + ro + bj * 128) = w;
                }
                asm volatile("" ::: "memory");
            }
    }
};
struct EpiBranch {
    static constexpr bool PERM = true, AFTER_DRAIN = false;
    const bf16* P; bf16* MM;
    __device__ __forceinline__ void operator()(const f32x4 (&acc)[2][2][4][2], const Unit& u, int wr, int wc, int fr, int fq) const {
        const int b = u.pn >> 2, pn = u.pn & 3, pm = u.pm - 66 * b;
        const int row0 = pm * 256 + wr * 64 + fr, col0 = pn * 256 + wc * 32 + 8 * fq;
#pragma unroll
        for (int ai = 0; ai < 2; ++ai)
#pragma unroll
            for (int m = 0; m < 4; ++m) {
                const int row = row0 + ai * 128 + m * 16;
                const bf16* gp = P + (size_t)row * PJ + 512 + b * 1024 + col0;
                bf16* mp = MM + (size_t)row * D + col0;
#pragma unroll
                for (int bj = 0; bj < 2; ++bj) {
                    const v4u gin = *(const v4u*)(gp + bj * 128);
                    const f32x4 v0 = acc[ai][bj][m][0], v1 = acc[ai][bj][m][1];
                    float o[8] = {bflo(gin.x) * v0[0], bfhi(gin.x) * v0[1], bflo(gin.y) * v0[2], bfhi(gin.y) * v0[3], bflo(gin.z) * v1[0], bfhi(gin.z) * v1[1], bflo(gin.w) * v1[2], bfhi(gin.w) * v1[3]};
                    if (b != 0) {
                        const unsigned long long* mq = (const unsigned long long*)(mp + bj * 128);
                        const unsigned long long q0 = __hip_atomic_load(mq, __ATOMIC_RELAXED, __HIP_MEMORY_SCOPE_AGENT), q1 = __hip_atomic_load(mq + 1, __ATOMIC_RELAXED, __HIP_MEMORY_SCOPE_AGENT);
                        v4u pv; pv.x = (unsigned)q0; pv.y = (unsigned)(q0 >> 32); pv.z = (unsigned)q1; pv.w = (unsigned)(q1 >> 32);
                        o[0] += bflo(pv.x); o[1] += bfhi(pv.x); o[2] += bflo(pv.y); o[3] += bfhi(pv.y); o[4] += bflo(pv.z); o[5] += bfhi(pv.z); o[6] += bflo(pv.w); o[7] += bfhi(pv.w); }
                    v4u w; w.x = pk2(o[0], o[1]); w.y = pk2(o[2], o[3]); w.z = pk2(o[4], o[5]); w.w = pk2(o[6], o[7]);
                    *(v4u*)(mp + bj * 128) = w;
                }
                asm volatile("" ::: "memory");
            }
    }
};
struct BranchOrder {
    int G, c;
    __device__ bool next(int i, Unit& u) const {
        const int T = (i / 3) * G + c, b = i % 3; if (T >= 264) return false;
        const int pm = T >> 2, pn = T & 3; u.pm = 66 * b + pm; u.pn = 4 * b + pn; return true;
    }
    __device__ __forceinline__ void a_ready(const Unit&) const {}
    __device__ __forceinline__ void done(const Unit&) const {}
};

__device__ __forceinline__ void transpose_item(const float* Wsrc  , int N, bf16* dst, int ldk, LAS float* scr, int lane) {
#pragma unroll 8
    for (int i = 0; i < 32; ++i) { const int kk = 2 * i + (lane >> 5); scr[kk * 33 + (lane & 31)] = Wsrc[(size_t)kk * N + (lane & 31)]; }
    asm volatile("s_waitcnt lgkmcnt(0)" ::: "memory");
    const int c = lane & 7;
#pragma unroll
    for (int j = 0; j < 4; ++j) { const int n = (lane >> 3) + 8 * j; const LAS float* s = scr + (8 * c) * 33 + n;
        v4u o; o.x = pk2(s[0 * 33], s[1 * 33]); o.y = pk2(s[2 * 33], s[3 * 33]); o.z = pk2(s[4 * 33], s[5 * 33]); o.w = pk2(s[6 * 33], s[7 * 33]);
        *(v4u*)(dst + (size_t)n * ldk + 8 * c) = o; }
    asm volatile("s_waitcnt lgkmcnt(0)" ::: "memory");
}

struct Args {
    const float* in[25]; float* out; unsigned char* ws;
};
struct Ctx {
    unsigned char* ws;
    __device__ __forceinline__ const float* in(int i) const { return ((const float* const*)(ws + WS_PTRS))[i]; }
    __device__ __forceinline__ float* out() const { return ((float* const*)(ws + WS_PTRS))[25]; }
};

constexpr int IT_UP = 16 * 88, IT_DN = 44 * 32, IT_IN = 16 * 208, IT_GLU = 8 * 16, IT_BR = 8 * 32, IT_OUT = 16 * 32;
constexpr int IT_LAYER = 4 * IT_UP + 2 * IT_DN + IT_IN + IT_GLU + 3 * IT_BR + IT_OUT;

__device__ __forceinline__ void convert_item(const Args& a, int it, LAS float* scr, int lane) {
    const int l = it / IT_LAYER; int r = it % IT_LAYER;
    unsigned char* wl = a.ws + WS_W + (size_t)l * WL_BYTES;
    if (r < 4 * IT_UP) {
        const int which = r / IT_UP, s = which >> 1, isu = which & 1; r %= IT_UP;
        const int kb = r / 88, nb = r % 88, k0 = 64 * kb, n0 = 32 * nb;
        const float* src = a.in[isu ? 9 : 8] + ((size_t)(l * 2 + s) * D + k0) * FF + n0;
        bf16* dst = (bf16*)(wl + (s ? WO_UP1 : WO_UP0)) + (size_t)(256 * (n0 >> 7) + (n0 & 127) + 128 * isu) * D + k0;
        transpose_item(src, FF, dst, D, scr, lane); return;
    }
    r -= 4 * IT_UP;
    if (r < 2 * IT_DN) {
        const int s = r / IT_DN; r %= IT_DN;
        const int kb = r / 32, nb = r % 32, k0 = 64 * kb, n0 = 32 * nb;
        const float* src = a.in[10] + ((size_t)(l * 2 + s) * FF + k0) * D + n0;
        bf16* dst = (bf16*)(wl + (s ? WO_DN1 : WO_DN0)) + (size_t)n0 * FF + k0;
        transpose_item(src, D, dst, FF, scr, lane); return;
    }
    r -= 2 * IT_DN;
    if (r < IT_IN) {
        const int kb = r / 208, nb = r % 208, k0 = 64 * kb, n0 = 32 * nb;
        const float* src = a.in[11] + ((size_t)l * D + k0) * DIN + n0;
        bf16* dst = (bf16*)(wl + WO_IN) + (size_t)n0 * D + k0;
        transpose_item(src, DIN, dst, D, scr, lane); return;
    }
    r -= IT_IN;
    if (r < IT_GLU) {
        const int kb = r / 16, nb = r % 16, k0 = 64 * kb, n0 = 32 * nb;
        const float* src = a.in[20] + ((size_t)l * 512 + k0) * 512 + n0;
        bf16* dst = (bf16*)(wl + WO_G) + (size_t)n0 * 512 + k0;
        transpose_item(src, 512, dst, 512, scr, lane); return;
    }
    r -= IT_GLU;
    if (r < 3 * IT_BR) {
        const int b = r / IT_BR; r %= IT_BR;
        const int kb = r / 32, nb = r % 32, k0 = 64 * kb, n0 = 32 * nb;
        const float* src = a.in[23] + ((size_t)(l * 3 + b) * 512 + k0) * D + n0;
        bf16* dst = (bf16*)(wl + WO_G) + (size_t)(512 + b * 1024 + n0) * 512 + k0;
        transpose_item(src, D, dst, 512, scr, lane); return;
    }
    r -= 3 * IT_BR;
    {
        const int kb = r / 32, nb = r % 32, k0 = 64 * kb, n0 = 32 * nb;
        const float* src = a.in[24] + ((size_t)l * D + k0) * D + n0;
        bf16* dst = (bf16*)(wl + WO_OUT) + (size_t)n0 * D + k0;
        transpose_item(src, D, dst, D, scr, lane);
    }
}

__device__ __forceinline__ void s5_tables(const Args& a, int idx) {
    const int p = idx & 63, g = (idx >> 6) & 31, dir = (idx >> 11) & 1, l = idx >> 12;
    const int ldg = (l * 2 + dir) * 32 + g;
    const double lr = (double)a.in[12][ldg * 64 + p], li = (double)a.in[13][ldg * 64 + p];
    const double dt = exp((double)a.in[14][ldg]);
    const double mag = exp(lr * dt); double sn, cs; sincos(li * dt, &sn, &cs);
    const double ar = mag * cs, ai = mag * sn;
    float* lam = (float*)(a.ws + WS_LAM); float* lamL = (float*)(a.ws + WS_LAML);
    lam[(ldg * 64 + p) * 2] = (float)ar; lam[(ldg * 64 + p) * 2 + 1] = (float)ai;
    double pr = ar, pi = ai;
#pragma unroll
    for (int i = 0; i < 7; ++i) { const double nr = pr * pr - pi * pi, ni = 2.0 * pr * pi; pr = nr; pi = ni; }
    lamL[(ldg * 64 + p) * 2] = (float)pr; lamL[(ldg * 64 + p) * 2 + 1] = (float)pi;
    const double den = lr * lr + li * li, nr = ar - 1.0, ni = ai;
    const double cr = (nr * lr + ni * li) / den, ci = (ni * lr - nr * li) / den;
    bf16* BB = (bf16*)(a.ws + WS_BB);
    const float* bre = a.in[15] + ((size_t)ldg * 64 + p) * 16; const float* bim = a.in[16] + ((size_t)ldg * 64 + p) * 16;
#pragma unroll
    for (int i = 0; i < 16; ++i) {
        const double br = bre[i], bi = bim[i];
        BB[(((size_t)ldg * 2 + 0) * 64 + p) * 16 + i] = (bf16)f2bf((float)(cr * br - ci * bi));
        BB[(((size_t)ldg * 2 + 1) * 64 + p) * 16 + i] = (bf16)f2bf((float)(cr * bi + ci * br));
    }
    bf16* CT = (bf16*)(a.ws + WS_CT);
    const float* cre = a.in[17] + (size_t)ldg * 16 * 64; const float* cim = a.in[18] + (size_t)ldg * 16 * 64;
#pragma unroll
    for (int h = 0; h < 16; ++h) {
        CT[((size_t)ldg * 16 + h) * 128 + 2 * p] = (bf16)f2bf(cre[h * 64 + p]);
        CT[((size_t)ldg * 16 + h) * 128 + 2 * p + 1] = (bf16)f2bf(-cim[h * 64 + p]);
    }
}

__device__ __forceinline__ void mod_row(const float* xrow, const float* shift, const float* scale, bf16* hrow, int lane) {
    const f32x4* xr = (const f32x4*)xrow + lane; const f32x4* sh = (const f32x4*)shift + lane; const f32x4* sc = (const f32x4*)scale + lane;
    unsigned long long* o8 = (unsigned long long*)hrow + lane;
#pragma unroll
    for (int j = 0; j < 4; ++j) { const f32x4 v = xr[64 * j] * (sc[64 * j] + 1.0f) + sh[64 * j];
        o8[64 * j] = (unsigned long long)pk2(v[0], v[1]) | ((unsigned long long)pk2(v[2], v[3]) << 32); }
}
__device__ __forceinline__ void ln_row(float* xrow, const float* g, const float* b, const float* shift, const float* scale, bf16* hrow, int lane) {
    f32x4* xr = (f32x4*)xrow + lane;
    f32x4 v[4]; float s = 0.f;
#pragma unroll
    for (int j = 0; j < 4; ++j) { v[j] = xr[64 * j]; s += (v[j][0] + v[j][1]) + (v[j][2] + v[j][3]); }
    const float mean = wave_sum(s) * (1.f / D); float s2 = 0.f;
#pragma unroll
    for (int j = 0; j < 4; ++j) { v[j] = v[j] - mean; s2 += (v[j][0] * v[j][0] + v[j][1] * v[j][1]) + (v[j][2] * v[j][2] + v[j][3] * v[j][3]); }
    const float rstd = 1.f / sqrtf(wave_sum(s2) * (1.f / D) + LN_EPS);
    const f32x4* gg = (const f32x4*)g + lane; const f32x4* bb = (const f32x4*)b + lane;
#pragma unroll
    for (int j = 0; j < 4; ++j) { v[j] = v[j] * rstd * gg[64 * j] + bb[64 * j]; xr[64 * j] = v[j]; }
    if (hrow) {
        const f32x4* sh = (const f32x4*)shift + lane; const f32x4* sc = (const f32x4*)scale + lane;
        unsigned long long* o8 = (unsigned long long*)hrow + lane;
#pragma unroll
        for (int j = 0; j < 4; ++j) { const f32x4 w = v[j] * (sc[64 * j] + 1.0f) + sh[64 * j];
            o8[64 * j] = (unsigned long long)pk2(w[0], w[1]) | ((unsigned long long)pk2(w[2], w[3]) << 32); }
    }
}

#define MFMA32(a, b, c) __builtin_amdgcn_mfma_f32_32x32x16_bf16((a), (b), (c), 0, 0, 0)
#define MFMA16(a, b, c) __builtin_amdgcn_mfma_f32_16x16x32_bf16((a), (b), (c), 0, 0, 0)
constexpr int S5_ROWB = 272, S5_BATB = 16 * S5_ROWB, S5_WAVEB = 2 * S5_BATB;

template <bool PASS2>
__device__ __forceinline__ void s5_task(const Ctx& a, int l, int g, int ch, LAS unsigned char* wl, int lane) {
    const int j = lane & 31, hl = lane >> 5;
    const bf16* P = (const bf16*)(a.ws + WS_A);
    const float* LAM = (const float*)(a.ws + WS_LAM); const float* LAML = (const float*)(a.ws + WS_LAML);
    const bf16* BB = (const bf16*)(a.ws + WS_BB); const bf16* CT = (const bf16*)(a.ws + WS_CT);
    float* E = (float*)(a.ws + WS_E);
    const int rb0 = ch < 2 ? RL + 128 * ch : 128 * (ch - 2), rbstep = ch < 2 ? CTXL : SEQ;
    const int arow = rb0 + ((j >> 2) & 1) * rbstep + 4 * (j >> 3) + (j & 3);
    const bf16* ap = P + (size_t)arow * PJ + COL_U + g * 16 + 8 * hl;
    f32x4 yacc[8][2];
    if (PASS2) {
#pragma unroll
        for (int sb = 0; sb < 8; ++sb) { yacc[sb][0] = (f32x4){0.f, 0.f, 0.f, 0.f}; yacc[sb][1] = (f32x4){0.f, 0.f, 0.f, 0.f}; }
    }
    const f32x16 zero16 = {0.f, 0.f, 0.f, 0.f, 0.f, 0.f, 0.f, 0.f, 0.f, 0.f, 0.f, 0.f, 0.f, 0.f, 0.f, 0.f};
#pragma unroll
    for (int dir = 0; dir < 2; ++dir) {
        const int ldg = (l * 2 + dir) * 32 + g;
        float lr[2], li[2], sr[2], si[2];
#pragma unroll
        for (int ph = 0; ph < 2; ++ph) { lr[ph] = LAM[(ldg * 64 + j + 32 * ph) * 2]; li[ph] = LAM[(ldg * 64 + j + 32 * ph) * 2 + 1]; sr[ph] = 0.f; si[ph] = 0.f; }
        if (PASS2) {
            float Lr[2], Li[2];
#pragma unroll
            for (int ph = 0; ph < 2; ++ph) { Lr[ph] = LAML[(ldg * 64 + j + 32 * ph) * 2]; Li[ph] = LAML[(ldg * 64 + j + 32 * ph) * 2 + 1]; }
            const float* Eb = E + ((size_t)((dir * 32 + g) * NCH) * 2 + hl) * 128 + 2 * j;
#define S5_FOLD(cp) do { const float* e_ = Eb + (size_t)(cp) * 256; _Pragma("unroll") for (int ph = 0; ph < 2; ++ph) { const float er = e_[64 * ph], ei = e_[64 * ph + 1]; \
                const float nr = Lr[ph] * sr[ph] - Li[ph] * si[ph] + er, ni = Lr[ph] * si[ph] + Li[ph] * sr[ph] + ei; sr[ph] = nr; si[ph] = ni; } } while (0)
            if (dir == 0) { for (int cp = 0; cp < ch; ++cp) S5_FOLD(cp); }
            else { if (ch == 0) { S5_FOLD(1); } else if (ch >= 2) { S5_FOLD(1); S5_FOLD(0); for (int cp = NCH - 1; cp > ch; --cp) S5_FOLD(cp); } }
#undef S5_FOLD
        }
        bf16x8 bfr[2][2];
#pragma unroll
        for (int ph = 0; ph < 2; ++ph)
#pragma unroll
            for (int ri = 0; ri < 2; ++ri) bfr[ph][ri] = *(const bf16x8*)(BB + (((size_t)ldg * 2 + ri) * 64 + j + 32 * ph) * 16 + 8 * hl);
        bf16x8 cfr[4];
        if (PASS2) {
#pragma unroll
            for (int ks = 0; ks < 4; ++ks) cfr[ks] = *(const bf16x8*)(CT + ((size_t)ldg * 16 + (lane & 15)) * 128 + 32 * ks + 8 * (lane >> 4));
        }
#pragma unroll
        for (int q = 0; q < (PASS2 ? 8 : 1); ++q)
#pragma unroll 1
        for (int q1 = 0; q1 < (PASS2 ? 1 : 8); ++q1) {
            const int sb = dir ? 7 - (q + q1) : (q + q1);
            const bf16* apq = ap; asm volatile("" : "+v"(apq));
            const bf16x8 uf = *(const bf16x8*)(apq + (size_t)(16 * sb) * PJ);
            f32x16 bu[2][2];
#pragma unroll
            for (int ph = 0; ph < 2; ++ph)
#pragma unroll
                for (int ri = 0; ri < 2; ++ri) bu[ph][ri] = MFMA32(uf, bfr[ph][ri], zero16);
#pragma unroll
            for (int rq = 0; rq < 16; ++rq) {
                const int r = dir ? 15 - rq : rq;
#pragma unroll
                for (int ph = 0; ph < 2; ++ph) {
                    const float nr = lr[ph] * sr[ph] - li[ph] * si[ph] + bu[ph][0][r], ni = lr[ph] * si[ph] + li[ph] * sr[ph] + bu[ph][1][r];
                    sr[ph] = nr; si[ph] = ni;
                    if (PASS2) *(LAS unsigned*)(wl + hl * S5_BATB + r * S5_ROWB + (j + 32 * ph) * 4) = pk2(nr, ni);
                }
            }
            if (PASS2) {
                asm volatile("s_waitcnt lgkmcnt(0)" ::: "memory");
#pragma unroll
                for (int bb = 0; bb < 2; ++bb)
#pragma unroll
                    for (int ks = 0; ks < 4; ++ks) {
                        const bf16x8 af = *(const LAS bf16x8*)(wl + bb * S5_BATB + (lane & 15) * S5_ROWB + (32 * ks + 8 * (lane >> 4)) * 2);
                        yacc[sb][bb] = MFMA16(af, cfr[ks], yacc[sb][bb]);
                    }
                asm volatile("s_waitcnt lgkmcnt(0)" ::: "memory");
            }
        }
        if (!PASS2) {
            float* e_ = E + ((size_t)((dir * 32 + g) * NCH + ch) * 2 + hl) * 128 + 2 * j;
#pragma unroll
            for (int ph = 0; ph < 2; ++ph) { e_[64 * ph] = sr[ph]; e_[64 * ph + 1] = si[ph]; }
        }
    }
    if (PASS2) {
        const int h = lane & 15, fq = lane >> 4;
        const float dv = a.in(19)[l * 512 + g * 16 + h];
        bf16* GA = (bf16*)(a.ws + WS_VT);
#pragma unroll
        for (int sb = 0; sb < 8; ++sb)
#pragma unroll
            for (int bb = 0; bb < 2; ++bb)
#pragma unroll
                for (int e = 0; e < 4; ++e) {
                    const int row = rb0 + bb * rbstep + 16 * sb + 4 * fq + e;
                    const float uu = bf2f(P[(size_t)row * PJ + COL_U + g * 16 + h]);
                    GA[(size_t)row * 512 + g * 16 + h] = (bf16)f2bf(gelu_tanh(yacc[sb][bb][e] + dv * uu));
                }
    }
}

constexpr float LOG2E = 1.4426950408889634f;
__device__ __forceinline__ void attn_task(const Ctx& a, int kind, int b, int h, int r, int jq, const LAS float* rpb  , int lane) {
    const int j = lane & 31, hl = lane >> 5;
    const bf16* P = (const bf16*)(a.ws + WS_A);
    const bf16* VT = (const bf16*)(a.ws + WS_VT) + (size_t)(b * 8 + h) * 64 * TOKP;
    bf16* YB = (bf16*)(a.ws + WS_Y3) + (size_t)R * 512;
    const int c = 32 * jq + j;
    const int rowq = kind == 0 ? b * SEQ + r * 64 + c : RL + b * CTXL + 32 * jq + j;
    bf16x8 qf[4];
#pragma unroll
    for (int s = 0; s < 4; ++s) qf[s] = *(const bf16x8*)(P + (size_t)rowq * PJ + COL_Q + h * 64 + 16 * s + 8 * hl);
    const int ka = j >> 3, kk = 16 * (ka >> 1) + 8 * ((j >> 2) & 1) + 4 * (ka & 1) + (j & 3);
    const f32x16 zero16 = {0.f, 0.f, 0.f, 0.f, 0.f, 0.f, 0.f, 0.f, 0.f, 0.f, 0.f, 0.f, 0.f, 0.f, 0.f, 0.f};
    f32x16 o0 = zero16, o1 = zero16;
    float m = -1e30f, lsum = 0.f;
    const int rs = min(max(r - 4, 0), 120), cs = min(max(c - 8, 0), 48);
    const float SC = 0.125f * LOG2E;
    const int ntile = kind == 0 ? 20 : 8;
    for (int t = 0; t < ntile; ++t) {
        int krow, tok0, tok1;
        int kr0 = 0, kc0 = 0;
        const bool win = t >= 8;
        if (!win) { krow = RL + b * CTXL + 32 * t + kk; tok0 = SEQ + 32 * t + 8 * hl; tok1 = tok0 + 16; }
        else { const int w = t - 8, jr2 = w / 3, cb = jq + (w - 3 * jr2); kr0 = rs + 2 * jr2; kc0 = 16 * cb;
            krow = b * SEQ + (kr0 + (kk >> 4)) * 64 + kc0 + (kk & 15); tok0 = kr0 * 64 + kc0 + 8 * hl; tok1 = tok0 + 64; }
        const bf16* kp = P + (size_t)krow * PJ + COL_K + h * 64 + 8 * hl;
        bf16x8 kf[4];
#pragma unroll
        for (int s = 0; s < 4; ++s) kf[s] = *(const bf16x8*)(kp + 16 * s);
        bf16x8 vf[2][2];
#pragma unroll
        for (int dh = 0; dh < 2; ++dh) { vf[0][dh] = *(const bf16x8*)(VT + (size_t)(32 * dh + j) * TOKP + tok0); vf[1][dh] = *(const bf16x8*)(VT + (size_t)(32 * dh + j) * TOKP + tok1); }
        f32x16 p = zero16;
#pragma unroll
        for (int s = 0; s < 4; ++s) p = MFMA32(kf[s], qf[s], p);
        float mx = -1e30f;
        if (!win) {
#pragma unroll
            for (int rr = 0; rr < 16; ++rr) { p[rr] *= SC; mx = fmaxf(mx, p[rr]); }
        } else {
            const LAS float* rp = rpb + h * 465;
#pragma unroll
            for (int rr = 0; rr < 16; ++rr) {
                const int kc = kc0 + 8 * hl + (rr & 7), kr = kr0 + (rr >> 3);
                const bool valid = (kc >= cs) && (kc < cs + 16);
                const int dc = min(max(kc - c + 15, 0), 30);
                const float bias = rp[(kr - r + 7) * 31 + dc];
                const float sv = valid ? p[rr] * SC + bias : -1e30f;
                p[rr] = sv; mx = fmaxf(mx, sv);
            }
        }
        mx = fmaxf(mx, __shfl_xor(mx, 32));
        const float mnew = fmaxf(m, mx), al = __builtin_amdgcn_exp2f(m - mnew);
        m = mnew;
        float ps = 0.f;
#pragma unroll
        for (int rr = 0; rr < 16; ++rr) { p[rr] = __builtin_amdgcn_exp2f(p[rr] - mnew); ps += p[rr]; }
        lsum = lsum * al + ps;
#pragma unroll
        for (int rr = 0; rr < 16; ++rr) { o0[rr] *= al; o1[rr] *= al; }
        bf16x8 pf[2];
#pragma unroll
        for (int sl = 0; sl < 2; ++sl) { v4u w; w.x = pk2(p[8 * sl], p[8 * sl + 1]); w.y = pk2(p[8 * sl + 2], p[8 * sl + 3]); w.z = pk2(p[8 * sl + 4], p[8 * sl + 5]); w.w = pk2(p[8 * sl + 6], p[8 * sl + 7]);
            pf[sl] = __builtin_bit_cast(bf16x8, w); }
#pragma unroll
        for (int sl = 0; sl < 2; ++sl) { o0 = MFMA32(vf[sl][0], pf[sl], o0); o1 = MFMA32(vf[sl][1], pf[sl], o1); }
    }
    const float ltot = lsum + __shfl_xor(lsum, 32), inv = 1.0f / ltot;
    bf16* yp = YB + (size_t)rowq * 512 + h * 64 + 4 * hl;
#pragma unroll
    for (int gq = 0; gq < 4; ++gq) {
        v2u w0, w1;
        w0.x = pk2(o0[4 * gq] * inv, o0[4 * gq + 1] * inv); w0.y = pk2(o0[4 * gq + 2] * inv, o0[4 * gq + 3] * inv);
        w1.x = pk2(o1[4 * gq] * inv, o1[4 * gq + 1] * inv); w1.y = pk2(o1[4 * gq + 2] * inv, o1[4 * gq + 3] * inv);
        *(v2u*)(yp + 8 * gq) = w0; *(v2u*)(yp + 32 + 8 * gq) = w1;
    }
}

__device__ __forceinline__ void conv_item(const Ctx& a, int l, int item) {
    const int row = item >> 6, ch = (item & 63) * 8;
    const bf16* P = (const bf16*)(a.ws + WS_A);
    bf16* YC = (bf16*)(a.ws + WS_Y3) + (size_t)2 * R * 512;
    int t, T; if (row < RL) { t = row & 8191; T = SEQ; } else { t = (row - RL) & 255; T = CTXL; }
    const float* cw = a.in(22) + (size_t)l * 3 * 512 + ch;
    float y[8] = {0.f, 0.f, 0.f, 0.f, 0.f, 0.f, 0.f, 0.f};
#pragma unroll
    for (int i = 0; i < 3; ++i) {
        const int tt = t + i - 1; if (tt < 0 || tt >= T) continue;
        const bf16* rp = P + (size_t)(row + i - 1) * PJ + ch;
        const v4u z = *(const v4u*)(rp + COL_Z), cg_ = *(const v4u*)(rp + COL_C);
        const f32x4 w0 = *(const f32x4*)(cw + i * 512), w1 = *(const f32x4*)(cw + i * 512 + 4);
        y[0] += w0[0] * bflo(z.x) * bflo(cg_.x); y[1] += w0[1] * bfhi(z.x) * bfhi(cg_.x); y[2] += w0[2] * bflo(z.y) * bflo(cg_.y); y[3] += w0[3] * bfhi(z.y) * bfhi(cg_.y);
        y[4] += w1[0] * bflo(z.z) * bflo(cg_.z); y[5] += w1[1] * bfhi(z.z) * bfhi(cg_.z); y[6] += w1[2] * bflo(z.w) * bflo(cg_.w); y[7] += w1[3] * bfhi(z.w) * bfhi(cg_.w);
    }
    const v4u bg = *(const v4u*)(P + (size_t)row * PJ + COL_B + ch);
    v4u w; w.x = pk2(y[0] * bflo(bg.x), y[1] * bfhi(bg.x)); w.y = pk2(y[2] * bflo(bg.y), y[3] * bfhi(bg.y)); w.z = pk2(y[4] * bflo(bg.z), y[5] * bfhi(bg.z)); w.w = pk2(y[6] * bflo(bg.w), y[7] * bfhi(bg.w));
    *(v4u*)(YC + (size_t)row * 512 + ch) = w;
}

template <class Epi, class Sched>
__device__ __forceinline__ void run_gemm(LAS unsigned char* lds, const bf16* A, const bf16* Bt, int M, int N, int K, const Sched& S, const Epi& E) {
    pg8::Gemm g{A, Bt, M, N, K};
    pg8::gemm_phase<Epi, Sched, true, true>(lds, g, S, E);
}

__global__ void __launch_bounds__(NWAVES * 64, 2) fwd_megakernel(Args a) {
    extern __shared__ __attribute__((aligned(16))) unsigned char lds_raw[];
    LAS unsigned char* lds = (LAS unsigned char*)lds_raw;
    LAS float* misc = (LAS float*)(lds + 131072);
    cg::grid_group grid = cg::this_grid();
    int tid = threadIdx.x, lane = tid & 63; int wave = __builtin_amdgcn_readfirstlane(tid >> 6);
    int G = gridDim.x, bx = blockIdx.x;
    int gw = bx * NWAVES + wave, NGW = G * NWAVES, NGT = G * NWAVES * 64; int gt = bx * (NWAVES * 64) + tid;
    Ctx c; c.ws = a.ws;
#define PHASE_OPAQUE() do { tid = threadIdx.x; asm volatile("" : "+v"(tid)); lane = tid & 63; { int b_ = blockIdx.x, g_ = gridDim.x; asm volatile("" : "+v"(b_), "+v"(g_)); bx = __builtin_amdgcn_readfirstlane(b_); G = __builtin_amdgcn_readfirstlane(g_); } \
        NGW = G * NWAVES; NGT = G * NWAVES * 64; gt = bx * (NWAVES * 64) + tid; wave = __builtin_amdgcn_readfirstlane(tid >> 6); gw = bx * NWAVES + wave; \
        unsigned lo_ = (unsigned)(uintptr_t)a.ws, hi_ = (unsigned)((uintptr_t)a.ws >> 32); asm volatile("" : "+v"(lo_), "+v"(hi_)); \
        lo_ = __builtin_amdgcn_readfirstlane(lo_); hi_ = __builtin_amdgcn_readfirstlane(hi_); c.ws = (unsigned char*)(((uintptr_t)hi_ << 32) | (uintptr_t)lo_); } while (0)
#define SYNC() do { asm volatile("s_waitcnt vmcnt(0)" ::: "memory"); __syncthreads(); \
        if (wave == 0) { __builtin_amdgcn_fence(__ATOMIC_RELEASE, "agent"); asm volatile("s_waitcnt vmcnt(0)" ::: "memory"); } \
        grid.sync(); \
        __builtin_amdgcn_fence(__ATOMIC_ACQUIRE, "agent"); asm volatile("s_waitcnt vmcnt(0)" ::: "memory"); __syncthreads(); \
        PHASE_OPAQUE(); } while (0)
#define WSP(T, off) ((T*)(c.ws + (off)))
#ifndef DBG_STOP
#define DBG_STOP -1
#endif
#define DBG(k, off, nelem) do { if (DBG_STOP == (k)) { if ((nelem) > 0) { const bf16* s_ = WSP(bf16, off); float* o_ = c.out(); \
        for (size_t i_ = (size_t)gt; i_ < (size_t)RL * D; i_ += (size_t)NGT) o_[i_] = bf2f(s_[i_ % (size_t)(nelem)]); } return; } } while (0)
#define XROW(row) ((row) < RL ? c.out() + (size_t)(row) * D : WSP(float, WS_XC) + (size_t)((row) - RL) * D)

    if (tid < 26) ((const float**)(a.ws + WS_PTRS))[tid] = tid < 25 ? a.in[tid] : (const float*)a.out;
    for (int i = tid; i < 3 * D; i += NWAVES * 64) { const int mid = i >> 10, k = i & 1023; const float cv = mid < 2 ? a.in[1][mid * D + k] : a.in[3][k]; misc[i] = cv / (1.0f + expf(-cv)); }
    __syncthreads();
    {
        float* modv = (float*)(a.ws + WS_MODV);
        for (int idx = gt; idx < 2 * 16 * NMODV; idx += NGT) {
            const int n = idx % NMODV, kc = (idx / NMODV) & 15, l = idx / (NMODV * 16);
            const float* w = a.in[4] + ((size_t)l * D + 64 * kc) * NMODV + n;
            float a0 = 0.f, a1 = 0.f, a2 = 0.f;
#pragma unroll 8
            for (int k = 0; k < 64; ++k) { const float wv = w[(size_t)k * NMODV]; a0 += misc[64 * kc + k] * wv; a1 += misc[D + 64 * kc + k] * wv; a2 += misc[2 * D + 64 * kc + k] * wv; }
            if (kc == 0) { const float bm = a.in[5][l * NMODV + n]; a0 += bm; a1 += bm; a2 += bm; }
            atomicAdd(modv + (size_t)(l * 3 + 0) * NMODV + n, a0); atomicAdd(modv + (size_t)(l * 3 + 1) * NMODV + n, a1); atomicAdd(modv + (size_t)(l * 3 + 2) * NMODV + n, a2);
        }
    }
    if (gt < 8192) s5_tables(a, gt);
    __syncthreads();
    {
        LAS float* scr = (LAS float*)(lds + wave * 16384);
        for (int it = gw; it < 2 * IT_LAYER; it += NGW) convert_item(a, it, scr, lane);
    }
    SYNC();
    for (int row = gw; row < R; row += NGW) {
        const float* xrow = row < RL ? c.in(0) + (size_t)row * D : c.in(2) + (size_t)(row - RL) * D;
        const float* mv = WSP(float, WS_MODV) + (size_t)mid_of_row(row) * NMODV;
        mod_row(xrow, mv, mv + D, WSP(bf16, WS_H) + (size_t)row * D, lane);
    }
    SYNC();

    DBG(1, WS_H, (size_t)R * D);
    DBG(2, WS_W, (size_t)WL_BYTES / 2);
#pragma unroll 1
    for (int l = 0; l < 2; ++l) {
#define WL(off) ((const bf16*)(c.ws + WS_W + (size_t)l * WL_BYTES + (off)))
#define MVL (WSP(float, WS_MODV) + (size_t)l * 3 * NMODV)
        pg8::StaticOrder SO;
        { SO.init(R, NUP, G, bx); EpiSwiglu E{WSP(bf16, WS_A)}; run_gemm(lds, WSP(bf16, WS_H), WL(WO_UP0), R, NUP, D, SO, E); }
        SYNC();
        DBG(10 + 100 * l, WS_A, (size_t)R * FF);
        { SO.init(R, D, G, bx); float* XL = c.out(); float* XC = WSP(float, WS_XC);
          EpiRes E{l == 0 ? c.in(0) : XL, l == 0 ? c.in(2) : XC, XL, XC, MVL + 2 * D, 0.5f}; run_gemm(lds, WSP(bf16, WS_A), WL(WO_DN0), R, D, FF, SO, E); }
        SYNC();
        DBG(11 + 100 * l, 0, 0);
        for (int row = gw; row < R; row += NGW) {
            const float* mv = MVL + (size_t)mid_of_row(row) * NMODV;
            ln_row(XROW(row), c.in(6) + (size_t)l * 3 * D, c.in(7) + (size_t)l * 3 * D, mv + 3 * D, mv + 4 * D, WSP(bf16, WS_H) + (size_t)row * D, lane);
        }
        SYNC();
        DBG(12 + 100 * l, WS_H, (size_t)R * D);
        { SO.init(R, PJ, G, bx); EpiProj E{WSP(bf16, WS_A), WSP(bf16, WS_VT)}; run_gemm(lds, WSP(bf16, WS_H), WL(WO_IN), R, PJ, D, SO, E); }
        SYNC();
        DBG(13 + 100 * l, WS_A, (size_t)R * PJ);
       DBG(14 + 100 * l, WS_VT, (size_t)R * 512);
        {
            const float* rpb = c.in(21) + (size_t)l * 8 * 465;
            for (int i = tid; i < 8 * 465; i += NWAVES * 64) misc[i] = rpb[i] * LOG2E;
            __syncthreads();
            const int natt = 4096 + (l == 0 ? 128 : 0);
            for (int u = gw; u < natt; u += NGW) {
                if (u < 4096) attn_task(c, 0, u >> 11, (u >> 8) & 7, (u >> 1) & 127, u & 1, misc, lane);
                else { const int v = u - 4096; attn_task(c, 1, v >> 6, (v >> 3) & 7, 0, v & 7, misc, lane); }
            }
            for (int t = NGW - 1 - gw; t < 32 * NCH; t += NGW) s5_task<false>(c, l, t / NCH, t % NCH, lds + wave * S5_WAVEB, lane);
            for (int item = gt; item < R * 64; item += NGT) conv_item(c, l, item);
        }
        SYNC();
        DBG(15 + 100 * l, WS_Y3 + (size_t)R * 512 * 2, (size_t)2 * R * 512);
        {
            for (int t = gw; t < 32 * NCH; t += NGW) s5_task<true>(c, l, t / NCH, t % NCH, lds + wave * S5_WAVEB, lane);
            asm volatile("s_waitcnt vmcnt(0) lgkmcnt(0)" ::: "memory");
            __syncthreads();
            PHASE_OPAQUE();
            SO.init(R, NGATE, G, bx); EpiGates E{WSP(bf16, WS_A)}; run_gemm(lds, WSP(bf16, WS_H), WL(WO_IN) + (size_t)PJ * D, R, NGATE, D, SO, E);
        }
        SYNC();
        DBG(16 + 100 * l, WS_VT, (size_t)R * 512);
        DBG(17 + 100 * l, WS_A, (size_t)R * PJ);
        { SO.init(R, 512, G, bx); EpiGlu E{WSP(bf16, WS_VT), WSP(bf16, WS_Y3)}; run_gemm(lds, WSP(bf16, WS_VT), WL(WO_G), R, 512, 512, SO, E); }
        SYNC();
        DBG(18 + 100 * l, WS_Y3, (size_t)R * 512);
        { BranchOrder BO{G, bx}; EpiBranch E{WSP(bf16, WS_A), WSP(bf16, WS_H)}; run_gemm(lds, WSP(bf16, WS_Y3), WL(WO_G) + (size_t)512 * 512, 3 * R, 3072, 512, BO, E); }
        SYNC();
        DBG(19 + 100 * l, WS_H, (size_t)R * D);
        { SO.init(R, D, G, bx); float* XL = c.out(); float* XC = WSP(float, WS_XC); EpiRes E{XL, XC, XL, XC, MVL + 5 * D, 1.0f}; run_gemm(lds, WSP(bf16, WS_H), WL(WO_OUT), R, D, D, SO, E); }
        SYNC();
        DBG(20 + 100 * l, 0, 0);
        for (int row = gw; row < R; row += NGW) {
            const float* mv = MVL + (size_t)mid_of_row(row) * NMODV;
            ln_row(XROW(row), c.in(6) + (size_t)(l * 3 + 1) * D, c.in(7) + (size_t)(l * 3 + 1) * D, mv + 6 * D, mv + 7 * D, WSP(bf16, WS_H) + (size_t)row * D, lane);
        }
        SYNC();
        DBG(21 + 100 * l, 0, 0);
        { SO.init(R, NUP, G, bx); EpiSwiglu E{WSP(bf16, WS_A)}; run_gemm(lds, WSP(bf16, WS_H), WL(WO_UP1), R, NUP, D, SO, E); }
        SYNC();
        { SO.init(R, D, G, bx); float* XL = c.out(); float* XC = WSP(float, WS_XC); EpiRes E{XL, XC, XL, XC, MVL + 8 * D, 0.5f}; run_gemm(lds, WSP(bf16, WS_A), WL(WO_DN1), R, D, FF, SO, E); }
        SYNC();
        for (int row = gw; row < R; row += NGW) {
            const float* mv = MVL + 3 * NMODV + (size_t)mid_of_row(row) * NMODV;
            ln_row(XROW(row), c.in(6) + (size_t)(l * 3 + 2) * D, c.in(7) + (size_t)(l * 3 + 2) * D, mv, mv + D, l == 0 ? WSP(bf16, WS_H) + (size_t)row * D : (bf16*)nullptr, lane);
        }
        if (l == 0) SYNC();
    }
}

extern "C" void kernel_launch(void* const* d_in, const int* in_sizes, int n_in, void* d_out, int out_size, void* d_ws, size_t ws_size, hipStream_t stream) {
    static int grid = 0;
    if (grid == 0) {
        if (n_in != 25 || in_sizes[0] != RL * D || out_size != RL * D || ws_size < WS_END) {
            fprintf(stderr, "kernel_launch: unexpected shapes (n_in %d, in0 %d, out %d, ws %zu, need %zu); nothing launched\n", n_in, n_in > 0 ? in_sizes[0] : -1, out_size, ws_size, (size_t)WS_END); grid = -1; return; }
        int dev = 0, cus = 0, per_cu = 0;
        if (hipGetDevice(&dev) != hipSuccess || hipDeviceGetAttribute(&cus, hipDeviceAttributeMultiprocessorCount, dev) != hipSuccess) { grid = -1; return; }
        if (hipFuncSetAttribute((const void*)fwd_megakernel, hipFuncAttributeMaxDynamicSharedMemorySize, LDS_BYTES) != hipSuccess) { fprintf(stderr, "kernel_launch: hipFuncSetAttribute failed\n"); grid = -1; return; }
        if (hipOccupancyMaxActiveBlocksPerMultiprocessor(&per_cu, (const void*)fwd_megakernel, NWAVES * 64, LDS_BYTES) != hipSuccess || per_cu < 1) { fprintf(stderr, "kernel_launch: occupancy query says %d\n", per_cu); grid = -1; return; }
        grid = cus;
    }
    if (grid < 0) return;
    (void)hipMemsetAsync((char*)d_ws + WS_MODV, 0, MODV_ZERO_BYTES, stream);
    Args a{};
    for (int i = 0; i < 25; ++i) a.in[i] = (const float*)d_in[i];
    a.out = (float*)d_out; a.ws = (unsigned char*)d_ws;
    void* args[] = {&a};
    const hipError_t e = hipLaunchCooperativeKernel((const void*)fwd_megakernel, dim3(grid), dim3(NWAVES * 64), args, LDS_BYTES, stream);
    if (e != hipSuccess) fprintf(stderr, "kernel_launch: cooperative launch failed: %s (grid %d)\n", hipGetErrorString(e), grid);
}
```

```cpp
#include <hip/hip_runtime.h>
#include <hip/hip_cooperative_groups.h>
#include <cstdio>
#include <cstdint>
namespace cg = cooperative_groups;

namespace pg8 {
#define PG8_LAS __attribute__((address_space(3)))
typedef unsigned short bf16_t;
typedef short bf16x8 __attribute__((ext_vector_type(8)));
typedef float f32x4 __attribute__((ext_vector_type(4)));
typedef unsigned u32x4 __attribute__((ext_vector_type(4)));
constexpr int BM = 256, BK = 64, HALF = 128, HTB = HALF * BK * 2  , STAGE_BYTES = 8 * HTB, NXCD = 8, WGM = 8;

__host__ __device__ __forceinline__ int lds_byte(int r, int c) { const int st = (r >> 4) * 2 + (c >> 5), rr = r & 15, cc = c & 31, ob = rr * 64 + cc * 2; return st * 1024 + (ob ^ (((ob >> 9) & 1) << 5)); }
__host__ __device__ __forceinline__ void stage_rc(int b, int& R, int& C) { const int st = b / 1024, sb = b % 1024, swz = sb ^ (((sb >> 9) & 1) << 5); R = (st >> 1) * 16 + swz / 64; C = (st & 1) * 32 + (swz % 64) / 2; }
__host__ __device__ __forceinline__ int perm32(int rho) { const int n = rho >> 4, i = rho & 15; return 8 * (i >> 2) + 4 * n + (i & 3); }

struct Unit { int pm, pn; };
struct Gemm { const bf16_t* A; const bf16_t* Bt; int M, N, K; };

struct StaticOrder {
    int nM, nN, nwg, G, c;
    __host__ __device__ void init(int M, int N, int G_, int c_) { nM = M / BM; nN = N / BM; nwg = nM * nN; G = G_; c = c_; }
    __host__ __device__ bool next(int i, Unit& u) const {
        const long L = (long)i * G + c; if (L >= nwg) return false;
        int wgid = (int)L; { const int q = nwg / NXCD, r = nwg % NXCD, xcd = wgid % NXCD, off = wgid / NXCD; wgid = (xcd < r ? xcd * (q + 1) : r * (q + 1) + (xcd - r) * q) + off; }
        const int nig = WGM * nN, gid = wgid / nig, fm = gid * WGM, gsz = (nM - fm) < WGM ? (nM - fm) : WGM;
        u.pm = fm + ((wgid % nig) % gsz); u.pn = (wgid % nig) / gsz; return true;
    }
    __device__ __forceinline__ void a_ready(const Unit&) const {}
    __device__ __forceinline__ void done(const Unit&) const {}
};
typedef float f32x2_cv __attribute__((ext_vector_type(2))); typedef __bf16 bf16x2_cv __attribute__((ext_vector_type(2)));
__device__ __forceinline__ unsigned cvt_pk_bf16(float lo, float hi) { f32x2_cv v = {lo, hi}; bf16x2_cv b = __builtin_convertvector(v, bf16x2_cv); return __builtin_bit_cast(unsigned, b); }
template <class Epi, class Sched, bool ALIGN_EPI = false, bool SP2 = false>
__device__ __forceinline__ void gemm_phase(PG8_LAS unsigned char* lds, const Gemm g, const Sched& S, const Epi& E) {
    int tid_ = threadIdx.x; asm volatile("" : "+v"(tid_));
    const int tid = tid_, wid = __builtin_amdgcn_readfirstlane(tid >> 6), lane = tid & 63, wr = wid >> 2, wc = wid & 3, fr = lane & 15, fq = lane >> 4;
    const int K = g.K, nt = K / BK;
    unsigned voffA[2], voffB[2];
#pragma unroll
    for (int i = 0; i < 2; ++i) { int R, C; stage_rc(tid * 16 + i * 8192, R, C); const int Rb = Epi::PERM ? ((R & ~31) + perm32(R & 31)) : R;
        voffA[i] = (unsigned)(R * K + C) * 2u; voffB[i] = (unsigned)(Rb * K + C) * 2u; }
    const size_t kstep = (size_t)(BK * 2);
    const size_t hstep = (size_t)HALF * K * 2;
    const size_t tstep = 2 * hstep;
    const unsigned ldsw = (unsigned)wid * 1024u;
    const int aoff = lds_byte(wr * 64 + fr, fq * 8), boff = lds_byte(wc * 32 + fr, fq * 8);
#define PG8_SA(b, h) (((b) * 2 + (h)) * HTB)
#define PG8_SB(b, h) ((4 + (b) * 2 + (h)) * HTB)
#define PG8_STAGE(bufoff, gbase, voff) do { _Pragma("unroll") for (int _i = 0; _i < 2; ++_i) \
        __builtin_amdgcn_global_load_lds((const unsigned*)((const char*)(gbase) + (voff)[_i]), (PG8_LAS unsigned*)(lds + (bufoff) + ldsw + _i * 8192), 16, 0, 0); } while (0)
#define PG8_LDA(dst, b, h) do { _Pragma("unroll") for (int m = 0; m < 4; ++m) _Pragma("unroll") for (int k = 0; k < 2; ++k) dst[m][k] = *(const PG8_LAS bf16x8*)(lds + PG8_SA(b, h) + aoff + m * 2048 + k * 1024); } while (0)
#define PG8_LDB(dst, b, h) do { _Pragma("unroll") for (int n = 0; n < 2; ++n) _Pragma("unroll") for (int k = 0; k < 2; ++k) dst[n][k] = *(const PG8_LAS bf16x8*)(lds + PG8_SB(b, h) + boff + n * 2048 + k * 1024); } while (0)
#define PG8_MMA(ai, bj, At, Bt) do { __builtin_amdgcn_s_setprio(1); _Pragma("unroll") for (int m = 0; m < 4; ++m) _Pragma("unroll") for (int n = 0; n < 2; ++n) _Pragma("unroll") for (int k = 0; k < 2; ++k) \
        acc[ai][bj][m][n] = __builtin_amdgcn_mfma_f32_16x16x32_bf16(Bt[n][k], At[m][k], acc[ai][bj][m][n], 0, 0, 0); __builtin_amdgcn_s_setprio(0); } while (0)
#define PG8_WAIT_V(n) asm volatile("s_waitcnt vmcnt(" #n ")" ::: "memory")
#define PG8_WAIT_L(n) asm volatile("s_waitcnt lgkmcnt(" #n ")" ::: "memory")
#define PG8_BAR __builtin_amdgcn_s_barrier()
#define PG8_SCHED __builtin_amdgcn_sched_barrier(0)
    Unit cur, nxt; int ui = 0;
    if (!S.next(0, cur)) return;
    f32x4 acc[2][2][4][2];
#pragma unroll
    for (int a = 0; a < 2; ++a)
#pragma unroll
        for (int b = 0; b < 2; ++b)
#pragma unroll
            for (int m = 0; m < 4; ++m)
#pragma unroll
                for (int n = 0; n < 2; ++n) acc[a][b][m][n] = (f32x4){0.f, 0.f, 0.f, 0.f};
    bf16x8 At[4][2], B0[2][2], B1[2][2];
    const char* cA = (const char*)g.A + (size_t)cur.pm * tstep; const char* cB = (const char*)g.Bt + (size_t)cur.pn * tstep;
    S.a_ready(cur);
    if constexpr (SP2) {
        PG8_STAGE(PG8_SB(0, 0), cB, voffB); PG8_STAGE(PG8_SB(0, 1), cB + hstep, voffB); PG8_STAGE(PG8_SA(0, 0), cA, voffA); PG8_STAGE(PG8_SA(0, 1), cA + hstep, voffA);
        if (wr == 1) PG8_BAR;
        PG8_WAIT_V(2); PG8_BAR;
        PG8_STAGE(PG8_SB(1, 0), cB + kstep, voffB); PG8_STAGE(PG8_SA(1, 0), cA + kstep, voffA); PG8_STAGE(PG8_SB(1, 1), cB + hstep + kstep, voffB);
        PG8_WAIT_V(6); PG8_BAR;
    } else {
        PG8_STAGE(PG8_SB(0, 0), cB, voffB); PG8_STAGE(PG8_SA(0, 0), cA, voffA); PG8_STAGE(PG8_SB(0, 1), cB + hstep, voffB); PG8_STAGE(PG8_SA(0, 1), cA + hstep, voffA);
        if (wr == 1) PG8_BAR;
        PG8_WAIT_V(4); PG8_BAR;
        PG8_STAGE(PG8_SB(1, 0), cB + kstep, voffB); PG8_STAGE(PG8_SA(1, 0), cA + kstep, voffA); PG8_STAGE(PG8_SB(1, 1), cB + hstep + kstep, voffB);
        PG8_WAIT_V(6); PG8_BAR;
    }
    for (;;) {
        const bool has_next = S.next(ui + 1, nxt);
        const char* nA = has_next ? (const char*)g.A + (size_t)nxt.pm * tstep : cA; const char* nB = has_next ? (const char*)g.Bt + (size_t)nxt.pn * tstep : cB;
        for (int t = 0; t < nt; t += 2) {
            const bool last = (t == nt - 2);
            const char* a1 = cA + (size_t)(t + 1) * kstep;
            const char* a2 = last ? nA : cA + (size_t)(t + 2) * kstep; const char* b2 = last ? nB : cB + (size_t)(t + 2) * kstep;
            const char* a3 = a2 + kstep; const char* b3 = b2 + kstep;
            if (last && has_next) S.a_ready(nxt);
            if constexpr (SP2) {
            PG8_LDB(B0, 0, 0); PG8_LDB(B1, 0, 1); PG8_SCHED; PG8_LDA(At, 0, 0); PG8_STAGE(PG8_SA(1, 1), a1 + hstep, voffA);
            PG8_WAIT_V(8); PG8_WAIT_L(0); PG8_BAR; PG8_MMA(0, 0, At, B0); PG8_MMA(0, 1, At, B1); PG8_BAR; PG8_SCHED;
            PG8_LDA(At, 0, 1); PG8_STAGE(PG8_SB(0, 0), b2, voffB); PG8_STAGE(PG8_SB(0, 1), b2 + hstep, voffB); PG8_STAGE(PG8_SA(0, 0), a2, voffA);
            PG8_WAIT_V(8); PG8_WAIT_L(0); PG8_BAR; PG8_MMA(1, 0, At, B0); PG8_MMA(1, 1, At, B1); PG8_BAR; PG8_SCHED;
            PG8_LDB(B0, 1, 0); PG8_LDB(B1, 1, 1); PG8_SCHED; PG8_LDA(At, 1, 0); PG8_STAGE(PG8_SA(0, 1), a2 + hstep, voffA);
            PG8_WAIT_V(8); PG8_WAIT_L(0); PG8_BAR; PG8_MMA(0, 0, At, B0); PG8_MMA(0, 1, At, B1); PG8_BAR; PG8_SCHED;
            PG8_LDA(At, 1, 1); PG8_STAGE(PG8_SB(1, 0), b3, voffB); PG8_STAGE(PG8_SB(1, 1), b3 + hstep, voffB); PG8_STAGE(PG8_SA(1, 0), a3, voffA);
            PG8_WAIT_V(8); PG8_WAIT_L(0); PG8_BAR; PG8_MMA(1, 0, At, B0); PG8_MMA(1, 1, At, B1); PG8_BAR; PG8_SCHED;
            } else {
            PG8_LDB(B0, 0, 0); PG8_SCHED; PG8_LDA(At, 0, 0); PG8_STAGE(PG8_SA(1, 1), a1 + hstep, voffA);
            PG8_WAIT_L(8); PG8_BAR; PG8_WAIT_L(0); PG8_MMA(0, 0, At, B0); PG8_BAR; PG8_SCHED;
            PG8_LDB(B1, 0, 1); PG8_STAGE(PG8_SB(0, 0), b2, voffB);
            PG8_BAR; PG8_WAIT_L(0); PG8_MMA(0, 1, At, B1); PG8_BAR;
            PG8_LDA(At, 0, 1); PG8_STAGE(PG8_SA(0, 0), a2, voffA);
            PG8_BAR; PG8_WAIT_L(0); PG8_MMA(1, 0, At, B0); PG8_BAR; PG8_SCHED;
            PG8_STAGE(PG8_SB(0, 1), b2 + hstep, voffB);
            PG8_WAIT_V(6); PG8_BAR; PG8_MMA(1, 1, At, B1); PG8_BAR;
            PG8_LDB(B0, 1, 0); PG8_SCHED; PG8_LDA(At, 1, 0); PG8_STAGE(PG8_SA(0, 1), a2 + hstep, voffA);
            PG8_WAIT_L(8); PG8_BAR; PG8_WAIT_L(0); PG8_MMA(0, 0, At, B0); PG8_BAR; PG8_SCHED;
            PG8_LDB(B1, 1, 1); PG8_STAGE(PG8_SB(1, 0), b3, voffB);
            PG8_BAR; PG8_WAIT_L(0); PG8_MMA(0, 1, At, B1); PG8_BAR;
            PG8_LDA(At, 1, 1); PG8_STAGE(PG8_SA(1, 0), a3, voffA);
            PG8_BAR; PG8_WAIT_L(0); PG8_MMA(1, 0, At, B0); PG8_BAR; PG8_SCHED;
            PG8_STAGE(PG8_SB(1, 1), b3 + hstep, voffB);
            PG8_WAIT_V(6); PG8_BAR; PG8_MMA(1, 1, At, B1); PG8_BAR;
            }
        }
        if constexpr (ALIGN_EPI) { if (wr == 0) PG8_BAR; }
        if constexpr (!Epi::AFTER_DRAIN) { E(acc, cur, wr, wc, fr, fq); S.done(cur); }
        if (!has_next) break;
#pragma unroll
        for (int a = 0; a < 2; ++a)
#pragma unroll
            for (int b = 0; b < 2; ++b)
#pragma unroll
                for (int m = 0; m < 4; ++m)
#pragma unroll
                    for (int n = 0; n < 2; ++n) acc[a][b][m][n] = (f32x4){0.f, 0.f, 0.f, 0.f};
        cur = nxt; cA = nA; cB = nB; ++ui;
        if constexpr (ALIGN_EPI) { if (wr == 1) PG8_BAR; }
    }
    PG8_WAIT_V(0);
    if constexpr (!ALIGN_EPI) { if (wr == 0) PG8_BAR; }
    PG8_BAR;
    if constexpr (Epi::AFTER_DRAIN) { E.fused(acc, cur, wr, wc, fr, fq, lds, wid, lane); S.done(cur); }
#undef PG8_SA
#undef PG8_SB
#undef PG8_STAGE
#undef PG8_LDA
#undef PG8_LDB
#undef PG8_MMA
#undef PG8_WAIT_V
#undef PG8_WAIT_L
#undef PG8_BAR
#undef PG8_SCHED
}
}

#define GAS __attribute__((address_space(1)))
#define LAS __attribute__((address_space(3)))
typedef unsigned short bf16;
typedef unsigned v4u __attribute__((ext_vector_type(4)));
typedef unsigned v2u __attribute__((ext_vector_type(2)));
typedef float f32x4 __attribute__((ext_vector_type(4)));
typedef float f32x16 __attribute__((ext_vector_type(16)));
typedef short bf16x8 __attribute__((ext_vector_type(8)));

constexpr int D = 1024, SEQ = 8192, CTXL = 256, RL = 16384, RC = 512, R = RL + RC, FF = 2816, NUP = 2 * FF;
constexpr int PJ = 3584;
constexpr int DIN = 6656, NGATE = 3072;
constexpr int COL_U = 0, COL_K = 512, COL_V = 1024, COL_Q = 1536, COL_Z = 2048, COL_B = 2560, COL_C = 3072;
constexpr int TOKP = SEQ + CTXL;
constexpr int NMODV = 9 * D;
constexpr float LN_EPS = 1e-5f;
constexpr float ALPHA = 1.4142135623730951f;
constexpr int NCH = 66;
constexpr int NWAVES = 8;

constexpr size_t KiB = 1024, MiB = 1024 * 1024;
constexpr size_t WS_MODV = 0, MODV_ZERO_BYTES = 256 * KiB;
constexpr size_t WS_BAR = 221184;
constexpr size_t WS_LAM = 256 * KiB, WS_LAML = 320 * KiB;
constexpr size_t WS_PTRS = 384 * KiB;
constexpr size_t WS_BB = 1 * MiB;
constexpr size_t WS_CT = 2 * MiB;
constexpr size_t WS_E = 3 * MiB;
constexpr size_t WS_W = 8 * MiB;
constexpr size_t WB_UP = (size_t)NUP * D * 2, WB_DN = (size_t)D * FF * 2, WB_IN = (size_t)DIN * D * 2, WB_G = (size_t)(512 + 3072) * 512 * 2, WB_OUT = (size_t)D * D * 2;
constexpr size_t WO_UP0 = 0, WO_UP1 = WB_UP, WO_DN0 = 2 * WB_UP, WO_DN1 = WO_DN0 + WB_DN, WO_IN = WO_DN1 + WB_DN, WO_G = WO_IN + WB_IN, WO_OUT = WO_G + WB_G, WL_BYTES = WO_OUT + WB_OUT;
constexpr size_t WS_XC = WS_W + 2 * WL_BYTES;
constexpr size_t WS_A = WS_XC + (size_t)RC * D * 4;
constexpr size_t WS_Y3 = WS_A + (size_t)R * PJ * 2;
constexpr size_t WS_H = WS_Y3 + (size_t)3 * R * 512 * 2;
constexpr size_t WS_VT = WS_H + (size_t)R * D * 2;
constexpr size_t WS_END = WS_VT + (size_t)R * 512 * 2;
static_assert(WS_E + (size_t)2 * 32 * NCH * 2 * 64 * 2 * 4 <= WS_W, "E fits");
static_assert((size_t)2 * 3 * 9 * 1024 * 4 <= WS_BAR && WS_BAR + 3456 * 4 <= MODV_ZERO_BYTES, "barrier words inside the zeroed region");
static_assert(WS_W % 256 == 0 && WL_BYTES % 256 == 0 && WS_A % 256 == 0 && WS_Y3 % 256 == 0 && WS_H % 256 == 0 && WS_VT % 256 == 0, "alignment");

constexpr int LDS_BYTES = 131072 + 16384;

__device__ __forceinline__ unsigned f2bf(float f) { unsigned u = __builtin_bit_cast(unsigned, f); return (u + 0x7fffu + ((u >> 16) & 1u)) >> 16; }
__device__ __forceinline__ unsigned pk2(float lo, float hi) { return pg8::cvt_pk_bf16(lo, hi); }
__device__ __forceinline__ float bf2f(unsigned short b) { return __builtin_bit_cast(float, (unsigned)b << 16); }
__device__ __forceinline__ float bflo(unsigned w) { return __builtin_bit_cast(float, w << 16); }
__device__ __forceinline__ float bfhi(unsigned w) { return __builtin_bit_cast(float, w & 0xffff0000u); }
__device__ __forceinline__ float sigmoidf_(float x) { return __builtin_amdgcn_rcpf(1.0f + __expf(-x)); }
__device__ __forceinline__ float siluf_(float x) { return x * sigmoidf_(x); }
__device__ __forceinline__ float gelu_tanh(float x) { const float u = 0.7978845608028654f * (x + 0.044715f * x * x * x); return x * sigmoidf_(2.0f * u); }
__device__ __forceinline__ float wave_sum(float v) {
#pragma unroll
    for (int o = 1; o < 64; o <<= 1) v += __shfl_xor(v, o);
    return v;
}
__device__ __forceinline__ int mid_of_row(int row) { return row < RL ? (row >> 13) : 2; }

using pg8::Unit;
struct EpiSwiglu {
    static constexpr bool PERM = true, AFTER_DRAIN = false;
    bf16* O;
    __device__ __forceinline__ void operator()(const f32x4 (&acc)[2][2][4][2], const Unit& u, int wr, int wc, int fr, int fq) const {
        const int row0 = u.pm * 256 + wr * 64 + fr, col0 = u.pn * 128 + wc * 32 + 8 * fq;
#pragma unroll
        for (int ai = 0; ai < 2; ++ai)
#pragma unroll
            for (int m = 0; m < 4; ++m) {
                bf16* rowp = O + (size_t)(row0 + ai * 128 + m * 16) * FF + col0;
                const f32x4 g0 = acc[ai][0][m][0], g1 = acc[ai][0][m][1], u0 = acc[ai][1][m][0], u1 = acc[ai][1][m][1];
                v4u w;
                w.x = pk2(siluf_(g0[0]) * u0[0], siluf_(g0[1]) * u0[1]); w.y = pk2(siluf_(g0[2]) * u0[2], siluf_(g0[3]) * u0[3]);
                w.z = pk2(siluf_(g1[0]) * u1[0], siluf_(g1[1]) * u1[1]); w.w = pk2(siluf_(g1[2]) * u1[2], siluf_(g1[3]) * u1[3]);
                *(v4u*)rowp = w;
            }
    }
};
struct EpiRes {
    static constexpr bool PERM = false, AFTER_DRAIN = false;
    const float* xin_lat; const float* xin_ctx; float* xout_lat; float* xout_ctx; const float* gate  ; float coef;
    __device__ __forceinline__ void operator()(const f32x4 (&acc)[2][2][4][2], const Unit& u, int wr, int wc, int fr, int fq) const {
        const bool lat = u.pm < 64;
        const float* xin = lat ? xin_lat + (size_t)u.pm * 256 * D : xin_ctx + (size_t)(u.pm - 64) * 256 * D;
        float* xout = lat ? xout_lat + (size_t)u.pm * 256 * D : xout_ctx + (size_t)(u.pm - 64) * 256 * D;
        const int mid = lat ? (u.pm >> 5) : 2;
        const int col0 = u.pn * 256 + wc * 32 + 4 * fq;
        const float* gp = gate + (size_t)mid * NMODV + col0;
#pragma unroll
        for (int bj = 0; bj < 2; ++bj)
#pragma unroll
            for (int n = 0; n < 2; ++n) {
                const f32x4 gv = *(const f32x4*)(gp + bj * 128 + n * 16) * coef;
#pragma unroll
                for (int ai = 0; ai < 2; ++ai)
#pragma unroll
                    for (int m = 0; m < 4; ++m) {
                        const size_t off = (size_t)(ai * 128 + wr * 64 + m * 16 + fr) * D + col0 + bj * 128 + n * 16;
                        const f32x4 xi = *(const f32x4*)(xin + off);
                        *(f32x4*)(xout + off) = xi * ALPHA + gv * acc[ai][bj][m][n];
                        asm volatile("" ::: "memory");
                    }
            }
    }
};
struct EpiProj {
    static constexpr bool PERM = true, AFTER_DRAIN = false;
    bf16* P; bf16* VT;
    __device__ __forceinline__ void operator()(const f32x4 (&acc)[2][2][4][2], const Unit& u, int wr, int wc, int fr, int fq) const {
        const int row0 = u.pm * 256 + wr * 64 + fr, col0 = u.pn * 256 + wc * 32 + 8 * fq;
        if (u.pn == 4 || u.pn == 5) {
#pragma unroll
            for (int ai = 0; ai < 2; ++ai)
#pragma unroll
                for (int m = 0; m < 4; ++m) {
                    const int row = row0 + ai * 128 + m * 16;
                    int b, tok; if (row < RL) { b = row >> 13; tok = row & 8191; } else { b = (row - RL) >> 8; tok = SEQ + ((row - RL) & 255); }
#pragma unroll
                    for (int bj = 0; bj < 2; ++bj)
#pragma unroll
                        for (int n = 0; n < 2; ++n)
#pragma unroll
                            for (int e = 0; e < 4; ++e) {
                                const int vc = col0 + bj * 128 + 4 * n + e - COL_V;
                                VT[((size_t)(b * 512 + vc)) * TOKP + tok] = (bf16)f2bf(acc[ai][bj][m][n][e]);
                            }
                }
        } else {
#pragma unroll
            for (int ai = 0; ai < 2; ++ai)
#pragma unroll
                for (int m = 0; m < 4; ++m) {
                    bf16* rowp = P + (size_t)(row0 + ai * 128 + m * 16) * PJ + col0;
#pragma unroll
                    for (int bj = 0; bj < 2; ++bj) {
                        const f32x4 v0 = acc[ai][bj][m][0], v1 = acc[ai][bj][m][1];
                        v4u w; w.x = pk2(v0[0], v0[1]); w.y = pk2(v0[2], v0[3]); w.z = pk2(v1[0], v1[1]); w.w = pk2(v1[2], v1[3]);
                        *(v4u*)(rowp + bj * 128) = w;
                    }
                }
        }
    }
};
struct EpiGates {
    static constexpr bool PERM = true, AFTER_DRAIN = false;
    bf16* P;
    __device__ __forceinline__ void operator()(const f32x4 (&acc)[2][2][4][2], const Unit& u, int wr, int wc, int fr, int fq) const {
        const int row0 = u.pm * 256 + wr * 64 + fr, col0 = 512 + u.pn * 256 + wc * 32 + 8 * fq;
#pragma unroll
        for (int ai = 0; ai < 2; ++ai)
#pragma unroll
            for (int m = 0; m < 4; ++m) {
                bf16* rowp = P + (size_t)(row0 + ai * 128 + m * 16) * PJ + col0;
#pragma unroll
                for (int bj = 0; bj < 2; ++bj) {
                    const f32x4 v0 = acc[ai][bj][m][0], v1 = acc[ai][bj][m][1];
                    v4u w; w.x = pk2(sigmoidf_(v0[0]), sigmoidf_(v0[1])); w.y = pk2(sigmoidf_(v0[2]), sigmoidf_(v0[3]));
                    w.z = pk2(sigmoidf_(v1[0]), sigmoidf_(v1[1])); w.w = pk2(sigmoidf_(v1[2]), sigmoidf_(v1[3]));
                    *(v4u*)(rowp + bj * 128) = w;
                }
            }
    }
};
struct EpiGlu {
    static constexpr bool PERM = true, AFTER_DRAIN = false;
    const bf16* GA; bf16* YA;
    __device__ __forceinline__ void operator()(const f32x4 (&acc)[2][2][4][2], const Unit& u, int wr, int wc, int fr, int fq) const {
        const int row0 = u.pm * 256 + wr * 64 + fr, col0 = u.pn * 256 + wc * 32 + 8 * fq;
#pragma unroll
        for (int ai = 0; ai < 2; ++ai)
#pragma unroll
            for (int m = 0; m < 4; ++m) {
                const size_t ro = (size_t)(row0 + ai * 128 + m * 16) * 512 + col0;
#pragma unroll
                for (int bj = 0; bj < 2; ++bj) {
                    const v4u gin = *(const v4u*)(GA + ro + bj * 128);
                    const f32x4 v0 = acc[ai][bj][m][0], v1 = acc[ai][bj][m][1];
                    v4u w;
                    w.x = pk2(bflo(gin.x) * sigmoidf_(v0[0]), bfhi(gin.x) * sigmoidf_(v0[1])); w.y = pk2(bflo(gin.y) * sigmoidf_(v0[2]), bfhi(gin.y) * sigmoidf_(v0[3]));
                    w.z = pk2(bflo(gin.z) * sigmoidf_(v1[0]), bfhi(gin.z) * sigmoidf_(v1[1])); w.w = pk2(bflo(gin.w) * sigmoidf_(v1[2]), bfhi(gin.w) * sigmoidf_(v1[3]));
                    *(v4u*)(YA + ro + bj * 128) = w;
                }
                asm volatile("" ::: "memory");
            }
    }
};
struct EpiBranch {
    static constexpr bool PERM = true, AFTER_DRAIN = false;
    const bf16* P; bf16* MM;
    __device__ __forceinline__ void operator()(const f32x4 (&acc)[2][2][4][2], const Unit& u, int wr, int wc, int fr, int fq) const {
        const int b = u.pn >> 2, pn = u.pn & 3, pm = u.pm - 66 * b;
        const int row0 = pm * 256 + wr * 64 + fr, col0 = pn * 256 + wc * 32 + 8 * fq;
#pragma unroll
        for (int ai = 0; ai < 2; ++ai)
#pragma unroll
            for (int m = 0; m < 4; ++m) {
                const int row = row0 + ai * 128 + m * 16;
                const bf16* gp = P + (size_t)row * PJ + 512 + b * 1024 + col0;
                bf16* mp = MM + (size_t)row * D + col0;
#pragma unroll
                for (int bj = 0; bj < 2; ++bj) {
                    const v4u gin = *(const v4u*)(gp + bj * 128);
                    const f32x4 v0 = acc[ai][bj][m][0], v1 = acc[ai][bj][m][1];
                    float o[8] = {bflo(gin.x) * v0[0], bfhi(gin.x) * v0[1], bflo(gin.y) * v0[2], bfhi(gin.y) * v0[3], bflo(gin.z) * v1[0], bfhi(gin.z) * v1[1], bflo(gin.w) * v1[2], bfhi(gin.w) * v1[3]};
                    if (b != 0) {
                        const unsigned long long* mq = (const unsigned long long*)(mp + bj * 128);
                        const unsigned long long q0 = __hip_atomic_load(mq, __ATOMIC_RELAXED, __HIP_MEMORY_SCOPE_AGENT), q1 = __hip_atomic_load(mq + 1, __ATOMIC_RELAXED, __HIP_MEMORY_SCOPE_AGENT);
                        v4u pv; pv.x = (unsigned)q0; pv.y = (unsigned)(q0 >> 32); pv.z = (unsigned)q1; pv.w = (unsigned)(q1 >> 32);
                        o[0] += bflo(pv.x); o[1] += bfhi(pv.x); o[2] += bflo(pv.y); o[3] += bfhi(pv.y); o[4] += bflo(pv.z); o[5] += bfhi(pv.z); o[6] += bflo(pv.w); o[7] += bfhi(pv.w); }
                    v4u w; w.x = pk2(o[0], o[1]); w.y = pk2(o[2], o[3]); w.z = pk2(o[4], o[5]); w.w = pk2(o[6], o[7]);
                    *(v4u*)(mp + bj * 128) = w;
                }
                asm volatile("" ::: "memory");
            }
    }
};
struct BranchOrder {
    int G, c;
    __device__ bool next(int i, Unit& u) const {
        const int T = (i / 3) * G + c, b = i % 3; if (T >= 264) return false;
        const int pm = T >> 2, pn = T & 3; u.pm = 66 * b + pm; u.pn = 4 * b + pn; return true;
    }
    __device__ __forceinline__ void a_ready(const Unit&) const {}
    __device__ __forceinline__ void done(const Unit&) const {}
};

__device__ __forceinline__ void transpose_item(const float* Wsrc  , int N, bf16* dst, int ldk, LAS float* scr, int lane) {
#pragma unroll 8
    for (int i = 0; i < 32; ++i) { const int kk = 2 * i + (lane >> 5); scr[kk * 33 + (lane & 31)] = Wsrc[(size_t)kk * N + (lane & 31)]; }
    asm volatile("s_waitcnt lgkmcnt(0)" ::: "memory");
    const int c = lane & 7;
#pragma unroll
    for (int j = 0; j < 4; ++j) { const int n = (lane >> 3) + 8 * j; const LAS float* s = scr + (8 * c) * 33 + n;
        v4u o; o.x = pk2(s[0 * 33], s[1 * 33]); o.y = pk2(s[2 * 33], s[3 * 33]); o.z = pk2(s[4 * 33], s[5 * 33]); o.w = pk2(s[6 * 33], s[7 * 33]);
        *(v4u*)(dst + (size_t)n * ldk + 8 * c) = o; }
    asm volatile("s_waitcnt lgkmcnt(0)" ::: "memory");
}

struct Args {
    const float* in[25]; float* out; unsigned char* ws;
};
struct Ctx {
    unsigned char* ws;
    __device__ __forceinline__ const float* in(int i) const { return ((const float* const*)(ws + WS_PTRS))[i]; }
    __device__ __forceinline__ float* out() const { return ((float* const*)(ws + WS_PTRS))[25]; }
};

constexpr int IT_UP = 16 * 88, IT_DN = 44 * 32, IT_IN = 16 * 208, IT_GLU = 8 * 16, IT_BR = 8 * 32, IT_OUT = 16 * 32;
constexpr int IT_LAYER = 4 * IT_UP + 2 * IT_DN + IT_IN + IT_GLU + 3 * IT_BR + IT_OUT;

__device__ __forceinline__ void convert_item(const Args& a, int it, LAS float* scr, int lane) {
    const int l = it / IT_LAYER; int r = it % IT_LAYER;
    unsigned char* wl = a.ws + WS_W + (size_t)l * WL_BYTES;
    if (r < 4 * IT_UP) {
        const int which = r / IT_UP, s = which >> 1, isu = which & 1; r %= IT_UP;
        const int kb = r / 88, nb = r % 88, k0 = 64 * kb, n0 = 32 * nb;
        const float* src = a.in[isu ? 9 : 8] + ((size_t)(l * 2 + s) * D + k0) * FF + n0;
        bf16* dst = (bf16*)(wl + (s ? WO_UP1 : WO_UP0)) + (size_t)(256 * (n0 >> 7) + (n0 & 127) + 128 * isu) * D + k0;
        transpose_item(src, FF, dst, D, scr, lane); return;
    }
    r -= 4 * IT_UP;
    if (r < 2 * IT_DN) {
        const int s = r / IT_DN; r %= IT_DN;
        const int kb = r / 32, nb = r % 32, k0 = 64 * kb, n0 = 32 * nb;
        const float* src = a.in[10] + ((size_t)(l * 2 + s) * FF + k0) * D + n0;
        bf16* dst = (bf16*)(wl + (s ? WO_DN1 : WO_DN0)) + (size_t)n0 * FF + k0;
        transpose_item(src, D, dst, FF, scr, lane); return;
    }
    r -= 2 * IT_DN;
    if (r < IT_IN) {
        const int kb = r / 208, nb = r % 208, k0 = 64 * kb, n0 = 32 * nb;
        const float* src = a.in[11] + ((size_t)l * D + k0) * DIN + n0;
        bf16* dst = (bf16*)(wl + WO_IN) + (size_t)n0 * D + k0;
        transpose_item(src, DIN, dst, D, scr, lane); return;
    }
    r -= IT_IN;
    if (r < IT_GLU) {
        const int kb = r / 16, nb = r % 16, k0 = 64 * kb, n0 = 32 * nb;
        const float* src = a.in[20] + ((size_t)l * 512 + k0) * 512 + n0;
        bf16* dst = (bf16*)(wl + WO_G) + (size_t)n0 * 512 + k0;
        transpose_item(src, 512, dst, 512, scr, lane); return;
    }
    r -= IT_GLU;
    if (r < 3 * IT_BR) {
        const int b = r / IT_BR; r %= IT_BR;
        const int kb = r / 32, nb = r % 32, k0 = 64 * kb, n0 = 32 * nb;
        const float* src = a.in[23] + ((size_t)(l * 3 + b) * 512 + k0) * D + n0;
        bf16* dst = (bf16*)(wl + WO_G) + (size_t)(512 + b * 1024 + n0) * 512 + k0;
        transpose_item(src, D, dst, 512, scr, lane); return;
    }
    r -= 3 * IT_BR;
    {
        const int kb = r / 32, nb = r % 32, k0 = 64 * kb, n0 = 32 * nb;
        const float* src = a.in[24] + ((size_t)l * D + k0) * D + n0;
        bf16* dst = (bf16*)(wl + WO_OUT) + (size_t)n0 * D + k0;
        transpose_item(src, D, dst, D, scr, lane);
    }
}

__device__ __forceinline__ void s5_tables(const Args& a, int idx) {
    const int p = idx & 63, g = (idx >> 6) & 31, dir = (idx >> 11) & 1, l = idx >> 12;
    const int ldg = (l * 2 + dir) * 32 + g;
    const double lr = (double)a.in[12][ldg * 64 + p], li = (double)a.in[13][ldg * 64 + p];
    const double dt = exp((double)a.in[14][ldg]);
    const double mag = exp(lr * dt); double sn, cs; sincos(li * dt, &sn, &cs);
    const double ar = mag * cs, ai = mag * sn;
    float* lam = (float*)(a.ws + WS_LAM); float* lamL = (float*)(a.ws + WS_LAML);
    lam[(ldg * 64 + p) * 2] = (float)ar; lam[(ldg * 64 + p) * 2 + 1] = (float)ai;
    double pr = ar, pi = ai;
#pragma unroll
    for (int i = 0; i < 7; ++i) { const double nr = pr * pr - pi * pi, ni = 2.0 * pr * pi; pr = nr; pi = ni; }
    lamL[(ldg * 64 + p) * 2] = (float)pr; lamL[(ldg * 64 + p) * 2 + 1] = (float)pi;
    const double den = lr * lr + li * li, nr = ar - 1.0, ni = ai;
    const double cr = (nr * lr + ni * li) / den, ci = (ni * lr - nr * li) / den;
    bf16* BB = (bf16*)(a.ws + WS_BB);
    const float* bre = a.in[15] + ((size_t)ldg * 64 + p) * 16; const float* bim = a.in[16] + ((size_t)ldg * 64 + p) * 16;
#pragma unroll
    for (int i = 0; i < 16; ++i) {
        const double br = bre[i], bi = bim[i];
        BB[(((size_t)ldg * 2 + 0) * 64 + p) * 16 + i] = (bf16)f2bf((float)(cr * br - ci * bi));
        BB[(((size_t)ldg * 2 + 1) * 64 + p) * 16 + i] = (bf16)f2bf((float)(cr * bi + ci * br));
    }
    bf16* CT = (bf16*)(a.ws + WS_CT);
    const float* cre = a.in[17] + (size_t)ldg * 16 * 64; const float* cim = a.in[18] + (size_t)ldg * 16 * 64;
#pragma unroll
    for (int h = 0; h < 16; ++h) {
        CT[((size_t)ldg * 16 + h) * 128 + 2 * p] = (bf16)f2bf(cre[h * 64 + p]);
        CT[((size_t)ldg * 16 + h) * 128 + 2 * p + 1] = (bf16)f2bf(-cim[h * 64 + p]);
    }
}

__device__ __forceinline__ void mod_row(const float* xrow, const float* shift, const float* scale, bf16* hrow, int lane) {
    const f32x4* xr = (const f32x4*)xrow + lane; const f32x4* sh = (const f32x4*)shift + lane; const f32x4* sc = (const f32x4*)scale + lane;
    unsigned long long* o8 = (unsigned long long*)hrow + lane;
#pragma unroll
    for (int j = 0; j < 4; ++j) { const f32x4 v = xr[64 * j] * (sc[64 * j] + 1.0f) + sh[64 * j];
        o8[64 * j] = (unsigned long long)pk2(v[0], v[1]) | ((unsigned long long)pk2(v[2], v[3]) << 32); }
}
__device__ __forceinline__ void ln_row(float* xrow, const float* g, const float* b, const float* shift, const float* scale, bf16* hrow, int lane) {
    f32x4* xr = (f32x4*)xrow + lane;
    f32x4 v[4]; float s = 0.f;
#pragma unroll
    for (int j = 0; j < 4; ++j) { v[j] = xr[64 * j]; s += (v[j][0] + v[j][1]) + (v[j][2] + v[j][3]); }
    const float mean = wave_sum(s) * (1.f / D); float s2 = 0.f;
#pragma unroll
    for (int j = 0; j < 4; ++j) { v[j] = v[j] - mean; s2 += (v[j][0] * v[j][0] + v[j][1] * v[j][1]) + (v[j][2] * v[j][2] + v[j][3] * v[j][3]); }
    const float rstd = 1.f / sqrtf(wave_sum(s2) * (1.f / D) + LN_EPS);
    const f32x4* gg = (const f32x4*)g + lane; const f32x4* bb = (const f32x4*)b + lane;
#pragma unroll
    for (int j = 0; j < 4; ++j) { v[j] = v[j] * rstd * gg[64 * j] + bb[64 * j]; xr[64 * j] = v[j]; }
    if (hrow) {
        const f32x4* sh = (const f32x4*)shift + lane; const f32x4* sc = (const f32x4*)scale + lane;
        unsigned long long* o8 = (unsigned long long*)hrow + lane;
#pragma unroll
        for (int j = 0; j < 4; ++j) { const f32x4 w = v[j] * (sc[64 * j] + 1.0f) + sh[64 * j];
            o8[64 * j] = (unsigned long long)pk2(w[0], w[1]) | ((unsigned long long)pk2(w[2], w[3]) << 32); }
    }
}

#define MFMA32(a, b, c) __builtin_amdgcn_mfma_f32_32x32x16_bf16((a), (b), (c), 0, 0, 0)
#define MFMA16(a, b, c) __builtin_amdgcn_mfma_f32_16x16x32_bf16((a), (b), (c), 0, 0, 0)
constexpr int S5_ROWB = 272, S5_BATB = 16 * S5_ROWB, S5_WAVEB = 2 * S5_BATB;

template <bool PASS2>
__device__ __forceinline__ void s5_task(const Ctx& a, int l, int g, int ch, LAS unsigned char* wl, int lane) {
    const int j = lane & 31, hl = lane >> 5;
    const bf16* P = (const bf16*)(a.ws + WS_A);
    const float* LAM = (const float*)(a.ws + WS_LAM); const float* LAML = (const float*)(a.ws + WS_LAML);
    const bf16* BB = (const bf16*)(a.ws + WS_BB); const bf16* CT = (const bf16*)(a.ws + WS_CT);
    float* E = (float*)(a.ws + WS_E);
    const int rb0 = ch < 2 ? RL + 128 * ch : 128 * (ch - 2), rbstep = ch < 2 ? CTXL : SEQ;
    const int arow = rb0 + ((j >> 2) & 1) * rbstep + 4 * (j >> 3) + (j & 3);
    const bf16* ap = P + (size_t)arow * PJ + COL_U + g * 16 + 8 * hl;
    f32x4 yacc[8][2];
    if (PASS2) {
#pragma unroll
        for (int sb = 0; sb < 8; ++sb) { yacc[sb][0] = (f32x4){0.f, 0.f, 0.f, 0.f}; yacc[sb][1] = (f32x4){0.f, 0.f, 0.f, 0.f}; }
    }
    const f32x16 zero16 = {0.f, 0.f, 0.f, 0.f, 0.f, 0.f, 0.f, 0.f, 0.f, 0.f, 0.f, 0.f, 0.f, 0.f, 0.f, 0.f};
#pragma unroll
    for (int dir = 0; dir < 2; ++dir) {
        const int ldg = (l * 2 + dir) * 32 + g;
        float lr[2], li[2], sr[2], si[2];
#pragma unroll
        for (int ph = 0; ph < 2; ++ph) { lr[ph] = LAM[(ldg * 64 + j + 32 * ph) * 2]; li[ph] = LAM[(ldg * 64 + j + 32 * ph) * 2 + 1]; sr[ph] = 0.f; si[ph] = 0.f; }
        if (PASS2) {
            float Lr[2], Li[2];
#pragma unroll
            for (int ph = 0; ph < 2; ++ph) { Lr[ph] = LAML[(ldg * 64 + j + 32 * ph) * 2]; Li[ph] = LAML[(ldg * 64 + j + 32 * ph) * 2 + 1]; }
            const float* Eb = E + ((size_t)((dir * 32 + g) * NCH) * 2 + hl) * 128 + 2 * j;
#define S5_FOLD(cp) do { const float* e_ = Eb + (size_t)(cp) * 256; _Pragma("unroll") for (int ph = 0; ph < 2; ++ph) { const float er = e_[64 * ph], ei = e_[64 * ph + 1]; \
                const float nr = Lr[ph] * sr[ph] - Li[ph] * si[ph] + er, ni = Lr[ph] * si[ph] + Li[ph] * sr[ph] + ei; sr[ph] = nr; si[ph] = ni; } } while (0)
            if (dir == 0) { for (int cp = 0; cp < ch; ++cp) S5_FOLD(cp); }
            else { if (ch == 0) { S5_FOLD(1); } else if (ch >= 2) { S5_FOLD(1); S5_FOLD(0); for (int cp = NCH - 1; cp > ch; --cp) S5_FOLD(cp); } }
#undef S5_FOLD
        }
        bf16x8 bfr[2][2];
#pragma unroll
        for (int ph = 0; ph < 2; ++ph)
#pragma unroll
            for (int ri = 0; ri < 2; ++ri) bfr[ph][ri] = *(const bf16x8*)(BB + (((size_t)ldg * 2 + ri) * 64 + j + 32 * ph) * 16 + 8 * hl);
        bf16x8 cfr[4];
        if (PASS2) {
#pragma unroll
            for (int ks = 0; ks < 4; ++ks) cfr[ks] = *(const bf16x8*)(CT + ((size_t)ldg * 16 + (lane & 15)) * 128 + 32 * ks + 8 * (lane >> 4));
        }
#pragma unroll
        for (int q = 0; q < (PASS2 ? 8 : 1); ++q)
#pragma unroll 1
        for (int q1 = 0; q1 < (PASS2 ? 1 : 8); ++q1) {
            const int sb = dir ? 7 - (q + q1) : (q + q1);
            const bf16* apq = ap; asm volatile("" : "+v"(apq));
            const bf16x8 uf = *(const bf16x8*)(apq + (size_t)(16 * sb) * PJ);
            f32x16 bu[2][2];
#pragma unroll
            for (int ph = 0; ph < 2; ++ph)
#pragma unroll
                for (int ri = 0; ri < 2; ++ri) bu[ph][ri] = MFMA32(uf, bfr[ph][ri], zero16);
#pragma unroll
            for (int rq = 0; rq < 16; ++rq) {
                const int r = dir ? 15 - rq : rq;
#pragma unroll
                for (int ph = 0; ph < 2; ++ph) {
                    const float nr = lr[ph] * sr[ph] - li[ph] * si[ph] + bu[ph][0][r], ni = lr[ph] * si[ph] + li[ph] * sr[ph] + bu[ph][1][r];
                    sr[ph] = nr; si[ph] = ni;
                    if (PASS2) *(LAS unsigned*)(wl + hl * S5_BATB + r * S5_ROWB + (j + 32 * ph) * 4) = pk2(nr, ni);
                }
            }
            if (PASS2) {
                asm volatile("s_waitcnt lgkmcnt(0)" ::: "memory");
#pragma unroll
                for (int bb = 0; bb < 2; ++bb)
#pragma unroll
                    for (int ks = 0; ks < 4; ++ks) {
                        const bf16x8 af = *(const LAS bf16x8*)(wl + bb * S5_BATB + (lane & 15) * S5_ROWB + (32 * ks + 8 * (lane >> 4)) * 2);
                        yacc[sb][bb] = MFMA16(af, cfr[ks], yacc[sb][bb]);
                    }
                asm volatile("s_waitcnt lgkmcnt(0)" ::: "memory");
            }
        }
        if (!PASS2) {
            float* e_ = E + ((size_t)((dir * 32 + g) * NCH + ch) * 2 + hl) * 128 + 2 * j;
#pragma unroll
            for (int ph = 0; ph < 2; ++ph) { e_[64 * ph] = sr[ph]; e_[64 * ph + 1] = si[ph]; }
        }
    }
    if (PASS2) {
        const int h = lane & 15, fq = lane >> 4;
        const float dv = a.in(19)[l * 512 + g * 16 + h];
        bf16* GA = (bf16*)(a.ws + WS_VT);
#pragma unroll
        for (int sb = 0; sb < 8; ++sb)
#pragma unroll
            for (int bb = 0; bb < 2; ++bb)
#pragma unroll
                for (int e = 0; e < 4; ++e) {
                    const int row = rb0 + bb * rbstep + 16 * sb + 4 * fq + e;
                    const float uu = bf2f(P[(size_t)row * PJ + COL_U + g * 16 + h]);
                    GA[(size_t)row * 512 + g * 16 + h] = (bf16)f2bf(gelu_tanh(yacc[sb][bb][e] + dv * uu));
                }
    }
}

constexpr float LOG2E = 1.4426950408889634f;
__device__ __forceinline__ void attn_task(const Ctx& a, int kind, int b, int h, int r, int jq, const LAS float* rpb  , int lane) {
    const int j = lane & 31, hl = lane >> 5;
    const bf16* P = (const bf16*)(a.ws + WS_A);
    const bf16* VT = (const bf16*)(a.ws + WS_VT) + (size_t)(b * 8 + h) * 64 * TOKP;
    bf16* YB = (bf16*)(a.ws + WS_Y3) + (size_t)R * 512;
    const int c = 32 * jq + j;
    const int rowq = kind == 0 ? b * SEQ + r * 64 + c : RL + b * CTXL + 32 * jq + j;
    bf16x8 qf[4];
#pragma unroll
    for (int s = 0; s < 4; ++s) qf[s] = *(const bf16x8*)(P + (size_t)rowq * PJ + COL_Q + h * 64 + 16 * s + 8 * hl);
    const int ka = j >> 3, kk = 16 * (ka >> 1) + 8 * ((j >> 2) & 1) + 4 * (ka & 1) + (j & 3);
    const f32x16 zero16 = {0.f, 0.f, 0.f, 0.f, 0.f, 0.f, 0.f, 0.f, 0.f, 0.f, 0.f, 0.f, 0.f, 0.f, 0.f, 0.f};
    f32x16 o0 = zero16, o1 = zero16;
    float m = -1e30f, lsum = 0.f;
    const int rs = min(max(r - 4, 0), 120), cs = min(max(c - 8, 0), 48);
    const float SC = 0.125f * LOG2E;
    const int ntile = kind == 0 ? 20 : 8;
    for (int t = 0; t < ntile; ++t) {
        int krow, tok0, tok1;
        int kr0 = 0, kc0 = 0;
        const bool win = t >= 8;
        if (!win) { krow = RL + b * CTXL + 32 * t + kk; tok0 = SEQ + 32 * t + 8 * hl; tok1 = tok0 + 16; }
        else { const int w = t - 8, jr2 = w / 3, cb = jq + (w - 3 * jr2); kr0 = rs + 2 * jr2; kc0 = 16 * cb;
            krow = b * SEQ + (kr0 + (kk >> 4)) * 64 + kc0 + (kk & 15); tok0 = kr0 * 64 + kc0 + 8 * hl; tok1 = tok0 + 64; }
        const bf16* kp = P + (size_t)krow * PJ + COL_K + h * 64 + 8 * hl;
        bf16x8 kf[4];
#pragma unroll
        for (int s = 0; s < 4; ++s) kf[s] = *(const bf16x8*)(kp + 16 * s);
        bf16x8 vf[2][2];
#pragma unroll
        for (int dh = 0; dh < 2; ++dh) { vf[0][dh] = *(const bf16x8*)(VT + (size_t)(32 * dh + j) * TOKP + tok0); vf[1][dh] = *(const bf16x8*)(VT + (size_t)(32 * dh + j) * TOKP + tok1); }
        f32x16 p = zero16;
#pragma unroll
        for (int s = 0; s < 4; ++s) p = MFMA32(kf[s], qf[s], p);
        float mx = -1e30f;
        if (!win) {
#pragma unroll
            for (int rr = 0; rr < 16; ++rr) { p[rr] *= SC; mx = fmaxf(mx, p[rr]); }
        } else {
            const LAS float* rp = rpb + h * 465;
#pragma unroll
            for (int rr = 0; rr < 16; ++rr) {
                const int kc = kc0 + 8 * hl + (rr & 7), kr = kr0 + (rr >> 3);
                const bool valid = (kc >= cs) && (kc < cs + 16);
                const int dc = min(max(kc - c + 15, 0), 30);
                const float bias = rp[(kr - r + 7) * 31 + dc];
                const float sv = valid ? p[rr] * SC + bias : -1e30f;
                p[rr] = sv; mx = fmaxf(mx, sv);
            }
        }
        mx = fmaxf(mx, __shfl_xor(mx, 32));
        const float mnew = fmaxf(m, mx), al = __builtin_amdgcn_exp2f(m - mnew);
        m = mnew;
        float ps = 0.f;
#pragma unroll
        for (int rr = 0; rr < 16; ++rr) { p[rr] = __builtin_amdgcn_exp2f(p[rr] - mnew); ps += p[rr]; }
        lsum = lsum * al + ps;
#pragma unroll
        for (int rr = 0; rr < 16; ++rr) { o0[rr] *= al; o1[rr] *= al; }
        bf16x8 pf[2];
#pragma unroll
        for (int sl = 0; sl < 2; ++sl) { v4u w; w.x = pk2(p[8 * sl], p[8 * sl + 1]); w.y = pk2(p[8 * sl + 2], p[8 * sl + 3]); w.z = pk2(p[8 * sl + 4], p[8 * sl + 5]); w.w = pk2(p[8 * sl + 6], p[8 * sl + 7]);
            pf[sl] = __builtin_bit_cast(bf16x8, w); }
#pragma unroll
        for (int sl = 0; sl < 2; ++sl) { o0 = MFMA32(vf[sl][0], pf[sl], o0); o1 = MFMA32(vf[sl][1], pf[sl], o1); }
    }
    const float ltot = lsum + __shfl_xor(lsum, 32), inv = 1.0f / ltot;
    bf16* yp = YB + (size_t)rowq * 512 + h * 64 + 4 * hl;
#pragma unroll
    for (int gq = 0; gq < 4; ++gq) {
        v2u w0, w1;
        w0.x = pk2(o0[4 * gq] * inv, o0[4 * gq + 1] * inv); w0.y = pk2(o0[4 * gq + 2] * inv, o0[4 * gq + 3] * inv);
        w1.x = pk2(o1[4 * gq] * inv, o1[4 * gq + 1] * inv); w1.y = pk2(o1[4 * gq + 2] * inv, o1[4 * gq + 3] * inv);
        *(v2u*)(yp + 8 * gq) = w0; *(v2u*)(yp + 32 + 8 * gq) = w1;
    }
}

__device__ __forceinline__ void conv_item(const Ctx& a, int l, int item) {
    const int row = item >> 6, ch = (item & 63) * 8;
    const bf16* P = (const bf16*)(a.ws + WS_A);
    bf16* YC = (bf16*)(a.ws + WS_Y3) + (size_t)2 * R * 512;
    int t, T; if (row < RL) { t = row & 8191; T = SEQ; } else { t = (row - RL) & 255; T = CTXL; }
    const float* cw = a.in(22) + (size_t)l * 3 * 512 + ch;
    float y[8] = {0.f, 0.f, 0.f, 0.f, 0.f, 0.f, 0.f, 0.f};
#pragma unroll
    for (int i = 0; i < 3; ++i) {
        const int tt = t + i - 1; if (tt < 0 || tt >= T) continue;
        const bf16* rp = P + (size_t)(row + i - 1) * PJ + ch;
        const v4u z = *(const v4u*)(rp + COL_Z), cg_ = *(const v4u*)(rp + COL_C);
        const f32x4 w0 = *(const f32x4*)(cw + i * 512), w1 = *(const f32x4*)(cw + i * 512 + 4);
        y[0] += w0[0] * bflo(z.x) * bflo(cg_.x); y[1] += w0[1] * bfhi(z.x) * bfhi(cg_.x); y[2] += w0[2] * bflo(z.y) * bflo(cg_.y); y[3] += w0[3] * bfhi(z.y) * bfhi(cg_.y);
        y[4] += w1[0] * bflo(z.z) * bflo(cg_.z); y[5] += w1[1] * bfhi(z.z) * bfhi(cg_.z); y[6] += w1[2] * bflo(z.w) * bflo(cg_.w); y[7] += w1[3] * bfhi(z.w) * bfhi(cg_.w);
    }
    const v4u bg = *(const v4u*)(P + (size_t)row * PJ + COL_B + ch);
    v4u w; w.x = pk2(y[0] * bflo(bg.x), y[1] * bfhi(bg.x)); w.y = pk2(y[2] * bflo(bg.y), y[3] * bfhi(bg.y)); w.z = pk2(y[4] * bflo(bg.z), y[5] * bfhi(bg.z)); w.w = pk2(y[6] * bflo(bg.w), y[7] * bfhi(bg.w));
    *(v4u*)(YC + (size_t)row * 512 + ch) = w;
}

typedef GAS unsigned gu32;
#define XB_TMO      128
#define XB_XCNT(j)  (256  + 64 * (j))
#define XB_XSUB(j)  (1280 + 64 * (j))
#define XB_XGEN(j)  (2304 + 64 * (j))
#define XB_TOP      3328
#define XB_TOPGEN   3392
#define XCD_BAR_WORDS 3456
#define XB_SPIN_CAP (1u << 18)

__device__ __forceinline__ unsigned xb_ld(unsigned* p)              { return __hip_atomic_load(p, __ATOMIC_RELAXED, __HIP_MEMORY_SCOPE_AGENT); }
__device__ __forceinline__ unsigned xb_add(unsigned* p, unsigned v) { return __hip_atomic_fetch_add(p, v, __ATOMIC_RELAXED, __HIP_MEMORY_SCOPE_AGENT); }
__device__ __forceinline__ unsigned xb_xcc_id() { return (unsigned)__builtin_amdgcn_s_getreg((3 << 11) | 20) & 0xFu; }
#define XB_SPIN(cond, bar) do { unsigned _sp = 0; while (cond) { __builtin_amdgcn_s_sleep(1); \
    if ((++_sp & 255u) == 0u) { if (xb_ld(&(bar)[XB_TMO])) break; if (_sp > XB_SPIN_CAP) { atomicAdd(&(bar)[XB_TMO], 1u); break; } } } } while (0)

struct XcdBarrier {
    unsigned* bar; unsigned x;
    volatile LAS unsigned* st;
};

__device__ __forceinline__ XcdBarrier xcd_barrier_post(unsigned* bar, volatile LAS unsigned* st) {
    XcdBarrier b; b.bar = bar; b.x = xb_xcc_id(); b.st = st;
    if (threadIdx.x == 0) (void)xb_add(&bar[XB_XCNT(b.x)], 1u);
    return b;
}
__device__ __forceinline__ void xcd_barrier_complete(unsigned* bar, unsigned x, unsigned& nloc, unsigned& nx) {
    const unsigned G = gridDim.x * gridDim.y * gridDim.z;
    unsigned sum, cnt, mine, sp = 0u;
    for (;;) {
        sum = 0u; cnt = 0u; mine = 0u;
#pragma unroll
        for (unsigned j = 0; j < 16; ++j) { const unsigned c = xb_ld(&bar[XB_XCNT(j)]); sum += c; cnt += (c > 0u) ? 1u : 0u; mine = (j == x) ? c : mine; }
        if (sum == G) break;
        __builtin_amdgcn_s_sleep(1);
        if ((++sp & 255u) == 0u) { if (xb_ld(&bar[XB_TMO])) break; if (sp > XB_SPIN_CAP) { atomicAdd(&bar[XB_TMO], 1u); break; } }
    }
    nloc = mine > 0u ? mine : 1u; nx = cnt > 0u ? cnt : 1u;
}

__device__ __forceinline__ void xcd_barrier(const XcdBarrier& b) {
    asm volatile("s_waitcnt vmcnt(0)" ::: "memory");
    __syncthreads();
    if (threadIdx.x == 0) {
        unsigned* bar = b.bar;
        __builtin_amdgcn_s_waitcnt(0);
        unsigned nloc = b.st[0], nx = b.st[1];
        if (nloc == 0u) { xcd_barrier_complete(bar, b.x, nloc, nx); b.st[0] = nloc; b.st[1] = nx; }
        const unsigned old = xb_add(&bar[XB_XSUB(b.x)], 1u);
        const unsigned gen = old / nloc;
        if (old + 1u == (gen + 1u) * nloc) {
            __builtin_amdgcn_fence(__ATOMIC_RELEASE, "agent");
            asm volatile("s_waitcnt vmcnt(0)" ::: "memory");
            const unsigned og = xb_add(&bar[XB_TOP], 1u);
            const unsigned tg = og / nx;
            if (og + 1u == (tg + 1u) * nx) xb_add(&bar[XB_TOPGEN], 1u);
            else XB_SPIN(xb_ld(&bar[XB_TOPGEN]) == tg, bar);
            __builtin_amdgcn_fence(__ATOMIC_ACQUIRE, "agent");
            xb_add(&bar[XB_XGEN(b.x)], 1u);
            asm volatile("s_waitcnt vmcnt(0)" ::: "memory");
        } else {
            XB_SPIN(xb_ld(&bar[XB_XGEN(b.x)]) == gen, bar);
            __builtin_amdgcn_fence(__ATOMIC_ACQUIRE, "agent");
            asm volatile("s_waitcnt vmcnt(0)" ::: "memory");
        }
    }
    __syncthreads();
}

template <class Epi, class Sched>
__device__ __forceinline__ void run_gemm(LAS unsigned char* lds, const bf16* A, const bf16* Bt, int M, int N, int K, const Sched& S, const Epi& E) {
    pg8::Gemm g{A, Bt, M, N, K};
    pg8::gemm_phase<Epi, Sched, true, true>(lds, g, S, E);
}

__global__ void __launch_bounds__(NWAVES * 64, 2) fwd_megakernel(Args a) {
    extern __shared__ __attribute__((aligned(16))) unsigned char lds_raw[];
    LAS unsigned char* lds = (LAS unsigned char*)lds_raw;
    LAS float* misc = (LAS float*)(lds + 131072);
    cg::grid_group grid = cg::this_grid();
    int tid = threadIdx.x, lane = tid & 63; int wave = __builtin_amdgcn_readfirstlane(tid >> 6);
    int G = gridDim.x, bx = blockIdx.x;
    int gw = bx * NWAVES + wave, NGW = G * NWAVES, NGT = G * NWAVES * 64; int gt = bx * (NWAVES * 64) + tid;
    Ctx c; c.ws = a.ws;
    volatile LAS unsigned* xst = (volatile LAS unsigned*)(lds + 131072 + 16128);
    if (tid < 2) xst[tid] = 0u;
    __syncthreads();
    (void)xcd_barrier_post((unsigned*)(a.ws + WS_BAR), xst);
#define PHASE_OPAQUE() do { tid = threadIdx.x; asm volatile("" : "+v"(tid)); lane = tid & 63; { int b_ = blockIdx.x, g_ = gridDim.x; asm volatile("" : "+v"(b_), "+v"(g_)); bx = __builtin_amdgcn_readfirstlane(b_); G = __builtin_amdgcn_readfirstlane(g_); } \
        NGW = G * NWAVES; NGT = G * NWAVES * 64; gt = bx * (NWAVES * 64) + tid; wave = __builtin_amdgcn_readfirstlane(tid >> 6); gw = bx * NWAVES + wave; \
        unsigned lo_ = (unsigned)(uintptr_t)a.ws, hi_ = (unsigned)((uintptr_t)a.ws >> 32); asm volatile("" : "+v"(lo_), "+v"(hi_)); \
        lo_ = __builtin_amdgcn_readfirstlane(lo_); hi_ = __builtin_amdgcn_readfirstlane(hi_); c.ws = (unsigned char*)(((uintptr_t)hi_ << 32) | (uintptr_t)lo_); } while (0)
#define SYNC() do { XcdBarrier b_; b_.bar = (unsigned*)(c.ws + WS_BAR); b_.x = xb_xcc_id(); b_.st = (volatile LAS unsigned*)(lds + 131072 + 16128); xcd_barrier(b_); PHASE_OPAQUE(); } while (0)
#define SYNC_CG() do { asm volatile("s_waitcnt vmcnt(0)" ::: "memory"); __syncthreads(); \
        if (wave == 0) { __builtin_amdgcn_fence(__ATOMIC_RELEASE, "agent"); asm volatile("s_waitcnt vmcnt(0)" ::: "memory"); } \
        grid.sync(); \
        __builtin_amdgcn_fence(__ATOMIC_ACQUIRE, "agent"); asm volatile("s_waitcnt vmcnt(0)" ::: "memory"); __syncthreads(); \
        PHASE_OPAQUE(); } while (0)
#define WSP(T, off) ((T*)(c.ws + (off)))
#ifndef DBG_STOP
#define DBG_STOP -1
#endif
#define DBG(k, off, nelem) do { if (DBG_STOP == (k)) { if ((nelem) > 0) { const bf16* s_ = WSP(bf16, off); float* o_ = c.out(); \
        for (size_t i_ = (size_t)gt; i_ < (size_t)RL * D; i_ += (size_t)NGT) o_[i_] = bf2f(s_[i_ % (size_t)(nelem)]); } return; } } while (0)
#define XROW(row) ((row) < RL ? c.out() + (size_t)(row) * D : WSP(float, WS_XC) + (size_t)((row) - RL) * D)

    if (tid < 26) ((const float**)(a.ws + WS_PTRS))[tid] = tid < 25 ? a.in[tid] : (const float*)a.out;
    for (int i = tid; i < 3 * D; i += NWAVES * 64) { const int mid = i >> 10, k = i & 1023; const float cv = mid < 2 ? a.in[1][mid * D + k] : a.in[3][k]; misc[i] = cv / (1.0f + expf(-cv)); }
    __syncthreads();
    {
        float* modv = (float*)(a.ws + WS_MODV);
        for (int idx = gt; idx < 2 * 16 * NMODV; idx += NGT) {
            const int n = idx % NMODV, kc = (idx / NMODV) & 15, l = idx / (NMODV * 16);
            const float* w = a.in[4] + ((size_t)l * D + 64 * kc) * NMODV + n;
            float a0 = 0.f, a1 = 0.f, a2 = 0.f;
#pragma unroll 8
            for (int k = 0; k < 64; ++k) { const float wv = w[(size_t)k * NMODV]; a0 += misc[64 * kc + k] * wv; a1 += misc[D + 64 * kc + k] * wv; a2 += misc[2 * D + 64 * kc + k] * wv; }
            if (kc == 0) { const float bm = a.in[5][l * NMODV + n]; a0 += bm; a1 += bm; a2 += bm; }
            atomicAdd(modv + (size_t)(l * 3 + 0) * NMODV + n, a0); atomicAdd(modv + (size_t)(l * 3 + 1) * NMODV + n, a1); atomicAdd(modv + (size_t)(l * 3 + 2) * NMODV + n, a2);
        }
    }
    if (gt < 8192) s5_tables(a, gt);
    __syncthreads();
    {
        LAS float* scr = (LAS float*)(lds + wave * 16384);
        for (int it = gw; it < 2 * IT_LAYER; it += NGW) convert_item(a, it, scr, lane);
    }
    SYNC_CG();
    for (int row = gw; row < R; row += NGW) {
        const float* xrow = row < RL ? c.in(0) + (size_t)row * D : c.in(2) + (size_t)(row - RL) * D;
        const float* mv = WSP(float, WS_MODV) + (size_t)mid_of_row(row) * NMODV;
        mod_row(xrow, mv, mv + D, WSP(bf16, WS_H) + (size_t)row * D, lane);
    }
    SYNC();

    DBG(1, WS_H, (size_t)R * D);
    DBG(2, WS_W, (size_t)WL_BYTES / 2);
#pragma unroll 1
    for (int l = 0; l < 2; ++l) {
#define WL(off) ((const bf16*)(c.ws + WS_W + (size_t)l * WL_BYTES + (off)))
#define MVL (WSP(float, WS_MODV) + (size_t)l * 3 * NMODV)
        pg8::StaticOrder SO;
        { SO.init(R, NUP, G, bx); EpiSwiglu E{WSP(bf16, WS_A)}; run_gemm(lds, WSP(bf16, WS_H), WL(WO_UP0), R, NUP, D, SO, E); }
        SYNC();
        DBG(10 + 100 * l, WS_A, (size_t)R * FF);
        { SO.init(R, D, G, bx); float* XL = c.out(); float* XC = WSP(float, WS_XC);
          EpiRes E{l == 0 ? c.in(0) : XL, l == 0 ? c.in(2) : XC, XL, XC, MVL + 2 * D, 0.5f}; run_gemm(lds, WSP(bf16, WS_A), WL(WO_DN0), R, D, FF, SO, E); }
        SYNC();
        DBG(11 + 100 * l, 0, 0);
        for (int row = gw; row < R; row += NGW) {
            const float* mv = MVL + (size_t)mid_of_row(row) * NMODV;
            ln_row(XROW(row), c.in(6) + (size_t)l * 3 * D, c.in(7) + (size_t)l * 3 * D, mv + 3 * D, mv + 4 * D, WSP(bf16, WS_H) + (size_t)row * D, lane);
        }
        SYNC();
        DBG(12 + 100 * l, WS_H, (size_t)R * D);
        { SO.init(R, PJ, G, bx); EpiProj E{WSP(bf16, WS_A), WSP(bf16, WS_VT)}; run_gemm(lds, WSP(bf16, WS_H), WL(WO_IN), R, PJ, D, SO, E); }
        SYNC();
        DBG(13 + 100 * l, WS_A, (size_t)R * PJ);
       DBG(14 + 100 * l, WS_VT, (size_t)R * 512);
        {
            const float* rpb = c.in(21) + (size_t)l * 8 * 465;
            for (int i = tid; i < 8 * 465; i += NWAVES * 64) misc[i] = rpb[i] * LOG2E;
            __syncthreads();
            const int natt = 4096 + (l == 0 ? 128 : 0);
            for (int u = gw; u < natt; u += NGW) {
                if (u < 4096) attn_task(c, 0, u >> 11, (u >> 8) & 7, (u >> 1) & 127, u & 1, misc, lane);
                else { const int v = u - 4096; attn_task(c, 1, v >> 6, (v >> 3) & 7, 0, v & 7, misc, lane); }
            }
            for (int t = NGW - 1 - gw; t < 32 * NCH; t += NGW) s5_task<false>(c, l, t / NCH, t % NCH, lds + wave * S5_WAVEB, lane);
            for (int item = gt; item < R * 64; item += NGT) conv_item(c, l, item);
        }
        SYNC();
        DBG(15 + 100 * l, WS_Y3 + (size_t)R * 512 * 2, (size_t)2 * R * 512);
        {
            for (int t = gw; t < 32 * NCH; t += NGW) s5_task<true>(c, l, t / NCH, t % NCH, lds + wave * S5_WAVEB, lane);
            asm volatile("s_waitcnt vmcnt(0) lgkmcnt(0)" ::: "memory");
            __syncthreads();
            PHASE_OPAQUE();
            SO.init(R, NGATE, G, bx); EpiGates E{WSP(bf16, WS_A)}; run_gemm(lds, WSP(bf16, WS_H), WL(WO_IN) + (size_t)PJ * D, R, NGATE, D, SO, E);
        }
        SYNC();
        DBG(16 + 100 * l, WS_VT, (size_t)R * 512);
        DBG(17 + 100 * l, WS_A, (size_t)R * PJ);
        { SO.init(R, 512, G, bx); EpiGlu E{WSP(bf16, WS_VT), WSP(bf16, WS_Y3)}; run_gemm(lds, WSP(bf16, WS_VT), WL(WO_G), R, 512, 512, SO, E); }
        SYNC();
        DBG(18 + 100 * l, WS_Y3, (size_t)R * 512);
        { BranchOrder BO{G, bx}; EpiBranch E{WSP(bf16, WS_A), WSP(bf16, WS_H)}; run_gemm(lds, WSP(bf16, WS_Y3), WL(WO_G) + (size_t)512 * 512, 3 * R, 3072, 512, BO, E); }
        SYNC();
        DBG(19 + 100 * l, WS_H, (size_t)R * D);
        { SO.init(R, D, G, bx); float* XL = c.out(); float* XC = WSP(float, WS_XC); EpiRes E{XL, XC, XL, XC, MVL + 5 * D, 1.0f}; run_gemm(lds, WSP(bf16, WS_H), WL(WO_OUT), R, D, D, SO, E); }
        SYNC();
        DBG(20 + 100 * l, 0, 0);
        for (int row = gw; row < R; row += NGW) {
            const float* mv = MVL + (size_t)mid_of_row(row) * NMODV;
            ln_row(XROW(row), c.in(6) + (size_t)(l * 3 + 1) * D, c.in(7) + (size_t)(l * 3 + 1) * D, mv + 6 * D, mv + 7 * D, WSP(bf16, WS_H) + (size_t)row * D, lane);
        }
        SYNC();
        DBG(21 + 100 * l, 0, 0);
        { SO.init(R, NUP, G, bx); EpiSwiglu E{WSP(bf16, WS_A)}; run_gemm(lds, WSP(bf16, WS_H), WL(WO_UP1), R, NUP, D, SO, E); }
        SYNC();
        { SO.init(R, D, G, bx); float* XL = c.out(); float* XC = WSP(float, WS_XC); EpiRes E{XL, XC, XL, XC, MVL + 8 * D, 0.5f}; run_gemm(lds, WSP(bf16, WS_A), WL(WO_DN1), R, D, FF, SO, E); }
        SYNC();
        for (int row = gw; row < R; row += NGW) {
            const float* mv = MVL + 3 * NMODV + (size_t)mid_of_row(row) * NMODV;
            ln_row(XROW(row), c.in(6) + (size_t)(l * 3 + 2) * D, c.in(7) + (size_t)(l * 3 + 2) * D, mv, mv + D, l == 0 ? WSP(bf16, WS_H) + (size_t)row * D : (bf16*)nullptr, lane);
        }
        if (l == 0) SYNC();
    }
}

extern "C" void kernel_launch(void* const* d_in, const int* in_sizes, int n_in, void* d_out, int out_size, void* d_ws, size_t ws_size, hipStream_t stream) {
    static int grid = 0;
    if (grid == 0) {
        if (n_in != 25 || in_sizes[0] != RL * D || out_size != RL * D || ws_size < WS_END) {
            fprintf(stderr, "kernel_launch: unexpected shapes (n_in %d, in0 %d, out %d, ws %zu, need %zu); nothing launched\n", n_in, n_in > 0 ? in_sizes[0] : -1, out_size, ws_size, (size_t)WS_END); grid = -1; return; }
        int dev = 0, cus = 0, per_cu = 0;
        if (hipGetDevice(&dev) != hipSuccess || hipDeviceGetAttribute(&cus, hipDeviceAttributeMultiprocessorCount, dev) != hipSuccess) { grid = -1; return; }
        if (hipFuncSetAttribute((const void*)fwd_megakernel, hipFuncAttributeMaxDynamicSharedMemorySize, LDS_BYTES) != hipSuccess) { fprintf(stderr, "kernel_launch: hipFuncSetAttribute failed\n"); grid = -1; return; }
        if (hipOccupancyMaxActiveBlocksPerMultiprocessor(&per_cu, (const void*)fwd_megakernel, NWAVES * 64, LDS_BYTES) != hipSuccess || per_cu < 1) { fprintf(stderr, "kernel_launch: occupancy query says %d\n", per_cu); grid = -1; return; }
        grid = cus;
    }
    if (grid < 0) return;
    (void)hipMemsetAsync((char*)d_ws + WS_MODV, 0, MODV_ZERO_BYTES, stream);
    Args a{};
    for (int i = 0; i < 25; ++i) a.in[i] = (const float*)d_in[i];
    a.out = (float*)d_out; a.ws = (unsigned char*)d_ws;
    void* args[] = {&a};
    const hipError_t e = hipLaunchCooperativeKernel((const void*)fwd_megakernel, dim3(grid), dim3(NWAVES * 64), args, LDS_BYTES, stream);
    if (e != hipSuccess) fprintf(stderr, "kernel_launch: cooperative launch failed: %s (grid %d)\n", hipGetErrorString(e), grid);
}
```

```cpp
#include <hip/hip_runtime.h>
#include <hip/hip_cooperative_groups.h>
#include <cstdio>
#include <cstdint>
namespace cg = cooperative_groups;

namespace pg8 {
#define PG8_LAS __attribute__((address_space(3)))
typedef unsigned short bf16_t;
typedef short bf16x8 __attribute__((ext_vector_type(8)));
typedef float f32x4 __attribute__((ext_vector_type(4)));
typedef unsigned u32x4 __attribute__((ext_vector_type(4)));
constexpr int BM = 256, BK = 64, HALF = 128, HTB = HALF * BK * 2  , STAGE_BYTES = 8 * HTB, NXCD = 8, WGM = 8;

__host__ __device__ __forceinline__ int lds_byte(int r, int c) { const int st = (r >> 4) * 2 + (c >> 5), rr = r & 15, cc = c & 31, ob = rr * 64 + cc * 2; return st * 1024 + (ob ^ (((ob >> 9) & 1) << 5)); }
__host__ __device__ __forceinline__ void stage_rc(int b, int& R, int& C) { const int st = b / 1024, sb = b % 1024, swz = sb ^ (((sb >> 9) & 1) << 5); R = (st >> 1) * 16 + swz / 64; C = (st & 1) * 32 + (swz % 64) / 2; }
__host__ __device__ __forceinline__ int perm32(int rho) { const int n = rho >> 4, i = rho & 15; return 8 * (i >> 2) + 4 * n + (i & 3); }

struct Unit { int pm, pn; };
struct Gemm { const bf16_t* A; const bf16_t* Bt; int M, N, K; };

struct StaticOrder {
    int nM, nN, nwg, G, c;
    __host__ __device__ void init(int M, int N, int G_, int c_) { nM = M / BM; nN = N / BM; nwg = nM * nN; G = G_; c = c_; }
    __host__ __device__ bool next(int i, Unit& u) const {
        const long L = (long)i * G + c; if (L >= nwg) return false;
        int wgid = (int)L; { const int q = nwg / NXCD, r = nwg % NXCD, xcd = wgid % NXCD, off = wgid / NXCD; wgid = (xcd < r ? xcd * (q + 1) : r * (q + 1) + (xcd - r) * q) + off; }
        const int nig = WGM * nN, gid = wgid / nig, fm = gid * WGM, gsz = (nM - fm) < WGM ? (nM - fm) : WGM;
        u.pm = fm + ((wgid % nig) % gsz); u.pn = (wgid % nig) / gsz; return true;
    }
    __device__ __forceinline__ void a_ready(const Unit&) const {}
    __device__ __forceinline__ void done(const Unit&) const {}
};
typedef float f32x2_cv __attribute__((ext_vector_type(2))); typedef __bf16 bf16x2_cv __attribute__((ext_vector_type(2)));
__device__ __forceinline__ unsigned cvt_pk_bf16(float lo, float hi) { f32x2_cv v = {lo, hi}; bf16x2_cv b = __builtin_convertvector(v, bf16x2_cv); return __builtin_bit_cast(unsigned, b); }
template <class Epi, class Sched, bool ALIGN_EPI = false, bool SP2 = false>
__device__ __forceinline__ void gemm_phase(PG8_LAS unsigned char* lds, const Gemm g, const Sched& S, const Epi& E) {
    int tid_ = threadIdx.x; asm volatile("" : "+v"(tid_));
    const int tid = tid_, wid = __builtin_amdgcn_readfirstlane(tid >> 6), lane = tid & 63, wr = wid >> 2, wc = wid & 3, fr = lane & 15, fq = lane >> 4;
    const int K = g.K, nt = K / BK;
    unsigned voffA[2], voffB[2];
#pragma unroll
    for (int i = 0; i < 2; ++i) { int R, C; stage_rc(tid * 16 + i * 8192, R, C); const int Rb = Epi::PERM ? ((R & ~31) + perm32(R & 31)) : R;
        voffA[i] = (unsigned)(R * K + C) * 2u; voffB[i] = (unsigned)(Rb * K + C) * 2u; }
    const size_t kstep = (size_t)(BK * 2);
    const size_t hstep = (size_t)HALF * K * 2;
    const size_t tstep = 2 * hstep;
    const unsigned ldsw = (unsigned)wid * 1024u;
    const int aoff = lds_byte(wr * 64 + fr, fq * 8), boff = lds_byte(wc * 32 + fr, fq * 8);
#define PG8_SA(b, h) (((b) * 2 + (h)) * HTB)
#define PG8_SB(b, h) ((4 + (b) * 2 + (h)) * HTB)
#define PG8_STAGE(bufoff, gbase, voff) do { _Pragma("unroll") for (int _i = 0; _i < 2; ++_i) \
        __builtin_amdgcn_global_load_lds((const unsigned*)((const char*)(gbase) + (voff)[_i]), (PG8_LAS unsigned*)(lds + (bufoff) + ldsw + _i * 8192), 16, 0, 0); } while (0)
#define PG8_LDA(dst, b, h) do { _Pragma("unroll") for (int m = 0; m < 4; ++m) _Pragma("unroll") for (int k = 0; k < 2; ++k) dst[m][k] = *(const PG8_LAS bf16x8*)(lds + PG8_SA(b, h) + aoff + m * 2048 + k * 1024); } while (0)
#define PG8_LDB(dst, b, h) do { _Pragma("unroll") for (int n = 0; n < 2; ++n) _Pragma("unroll") for (int k = 0; k < 2; ++k) dst[n][k] = *(const PG8_LAS bf16x8*)(lds + PG8_SB(b, h) + boff + n * 2048 + k * 1024); } while (0)
#define PG8_MMA(ai, bj, At, Bt) do { __builtin_amdgcn_s_setprio(1); _Pragma("unroll") for (int m = 0; m < 4; ++m) _Pragma("unroll") for (int n = 0; n < 2; ++n) _Pragma("unroll") for (int k = 0; k < 2; ++k) \
        acc[ai][bj][m][n] = __builtin_amdgcn_mfma_f32_16x16x32_bf16(Bt[n][k], At[m][k], acc[ai][bj][m][n], 0, 0, 0); __builtin_amdgcn_s_setprio(0); } while (0)
#define PG8_WAIT_V(n) asm volatile("s_waitcnt vmcnt(" #n ")" ::: "memory")
#define PG8_WAIT_L(n) asm volatile("s_waitcnt lgkmcnt(" #n ")" ::: "memory")
#define PG8_BAR __builtin_amdgcn_s_barrier()
#define PG8_SCHED __builtin_amdgcn_sched_barrier(0)
    Unit cur, nxt; int ui = 0;
    if (!S.next(0, cur)) return;
    f32x4 acc[2][2][4][2];
#pragma unroll
    for (int a = 0; a < 2; ++a)
#pragma unroll
        for (int b = 0; b < 2; ++b)
#pragma unroll
            for (int m = 0; m < 4; ++m)
#pragma unroll
                for (int n = 0; n < 2; ++n) acc[a][b][m][n] = (f32x4){0.f, 0.f, 0.f, 0.f};
    bf16x8 At[4][2], B0[2][2], B1[2][2];
    const char* cA = (const char*)g.A + (size_t)cur.pm * tstep; const char* cB = (const char*)g.Bt + (size_t)cur.pn * tstep;
    S.a_ready(cur);
    if constexpr (SP2) {
        PG8_STAGE(PG8_SB(0, 0), cB, voffB); PG8_STAGE(PG8_SB(0, 1), cB + hstep, voffB); PG8_STAGE(PG8_SA(0, 0), cA, voffA); PG8_STAGE(PG8_SA(0, 1), cA + hstep, voffA);
        if (wr == 1) PG8_BAR;
        PG8_WAIT_V(2); PG8_BAR;
        PG8_STAGE(PG8_SB(1, 0), cB + kstep, voffB); PG8_STAGE(PG8_SA(1, 0), cA + kstep, voffA); PG8_STAGE(PG8_SB(1, 1), cB + hstep + kstep, voffB);
        PG8_WAIT_V(6); PG8_BAR;
    } else {
        PG8_STAGE(PG8_SB(0, 0), cB, voffB); PG8_STAGE(PG8_SA(0, 0), cA, voffA); PG8_STAGE(PG8_SB(0, 1), cB + hstep, voffB); PG8_STAGE(PG8_SA(0, 1), cA + hstep, voffA);
        if (wr == 1) PG8_BAR;
        PG8_WAIT_V(4); PG8_BAR;
        PG8_STAGE(PG8_SB(1, 0), cB + kstep, voffB); PG8_STAGE(PG8_SA(1, 0), cA + kstep, voffA); PG8_STAGE(PG8_SB(1, 1), cB + hstep + kstep, voffB);
        PG8_WAIT_V(6); PG8_BAR;
    }
    for (;;) {
        const bool has_next = S.next(ui + 1, nxt);
        const char* nA = has_next ? (const char*)g.A + (size_t)nxt.pm * tstep : cA; const char* nB = has_next ? (const char*)g.Bt + (size_t)nxt.pn * tstep : cB;
        for (int t = 0; t < nt; t += 2) {
            const bool last = (t == nt - 2);
            const char* a1 = cA + (size_t)(t + 1) * kstep;
            const char* a2 = last ? nA : cA + (size_t)(t + 2) * kstep; const char* b2 = last ? nB : cB + (size_t)(t + 2) * kstep;
            const char* a3 = a2 + kstep; const char* b3 = b2 + kstep;
            if (last && has_next) S.a_ready(nxt);
            if constexpr (SP2) {
            PG8_LDB(B0, 0, 0); PG8_LDB(B1, 0, 1); PG8_SCHED; PG8_LDA(At, 0, 0); PG8_STAGE(PG8_SA(1, 1), a1 + hstep, voffA);
            PG8_WAIT_V(8); PG8_WAIT_L(0); PG8_BAR; PG8_MMA(0, 0, At, B0); PG8_MMA(0, 1, At, B1); PG8_BAR; PG8_SCHED;
            PG8_LDA(At, 0, 1); PG8_STAGE(PG8_SB(0, 0), b2, voffB); PG8_STAGE(PG8_SB(0, 1), b2 + hstep, voffB); PG8_STAGE(PG8_SA(0, 0), a2, voffA);
            PG8_WAIT_V(8); PG8_WAIT_L(0); PG8_BAR; PG8_MMA(1, 0, At, B0); PG8_MMA(1, 1, At, B1); PG8_BAR; PG8_SCHED;
            PG8_LDB(B0, 1, 0); PG8_LDB(B1, 1, 1); PG8_SCHED; PG8_LDA(At, 1, 0); PG8_STAGE(PG8_SA(0, 1), a2 + hstep, voffA);
            PG8_WAIT_V(8); PG8_WAIT_L(0); PG8_BAR; PG8_MMA(0, 0, At, B0); PG8_MMA(0, 1, At, B1); PG8_BAR; PG8_SCHED;
            PG8_LDA(At, 1, 1); PG8_STAGE(PG8_SB(1, 0), b3, voffB); PG8_STAGE(PG8_SB(1, 1), b3 + hstep, voffB); PG8_STAGE(PG8_SA(1, 0), a3, voffA);
            PG8_WAIT_V(8); PG8_WAIT_L(0); PG8_BAR; PG8_MMA(1, 0, At, B0); PG8_MMA(1, 1, At, B1); PG8_BAR; PG8_SCHED;
            } else {
            PG8_LDB(B0, 0, 0); PG8_SCHED; PG8_LDA(At, 0, 0); PG8_STAGE(PG8_SA(1, 1), a1 + hstep, voffA);
            PG8_WAIT_L(8); PG8_BAR; PG8_WAIT_L(0); PG8_MMA(0, 0, At, B0); PG8_BAR; PG8_SCHED;
            PG8_LDB(B1, 0, 1); PG8_STAGE(PG8_SB(0, 0), b2, voffB);
            PG8_BAR; PG8_WAIT_L(0); PG8_MMA(0, 1, At, B1); PG8_BAR;
            PG8_LDA(At, 0, 1); PG8_STAGE(PG8_SA(0, 0), a2, voffA);
            PG8_BAR; PG8_WAIT_L(0); PG8_MMA(1, 0, At, B0); PG8_BAR; PG8_SCHED;
            PG8_STAGE(PG8_SB(0, 1), b2 + hstep, voffB);
            PG8_WAIT_V(6); PG8_BAR; PG8_MMA(1, 1, At, B1); PG8_BAR;
            PG8_LDB(B0, 1, 0); PG8_SCHED; PG8_LDA(At, 1, 0); PG8_STAGE(PG8_SA(0, 1), a2 + hstep, voffA);
            PG8_WAIT_L(8); PG8_BAR; PG8_WAIT_L(0); PG8_MMA(0, 0, At, B0); PG8_BAR; PG8_SCHED;
            PG8_LDB(B1, 1, 1); PG8_STAGE(PG8_SB(1, 0), b3, voffB);
            PG8_BAR; PG8_WAIT_L(0); PG8_MMA(0, 1, At, B1); PG8_BAR;
            PG8_LDA(At, 1, 1); PG8_STAGE(PG8_SA(1, 0), a3, voffA);
            PG8_BAR; PG8_WAIT_L(0); PG8_MMA(1, 0, At, B0); PG8_BAR; PG8_SCHED;
            PG8_STAGE(PG8_SB(1, 1), b3 + hstep, voffB);
            PG8_WAIT_V(6); PG8_BAR; PG8_MMA(1, 1, At, B1); PG8_BAR;
            }
        }
        if constexpr (ALIGN_EPI) { if (wr == 0) PG8_BAR; }
        if constexpr (!Epi::AFTER_DRAIN) { E(acc, cur, wr, wc, fr, fq); S.done(cur); }
        if (!has_next) break;
#pragma unroll
        for (int a = 0; a < 2; ++a)
#pragma unroll
            for (int b = 0; b < 2; ++b)
#pragma unroll
                for (int m = 0; m < 4; ++m)
#pragma unroll
                    for (int n = 0; n < 2; ++n) acc[a][b][m][n] = (f32x4){0.f, 0.f, 0.f, 0.f};
        cur = nxt; cA = nA; cB = nB; ++ui;
        if constexpr (ALIGN_EPI) { if (wr == 1) PG8_BAR; }
    }
    PG8_WAIT_V(0);
    if constexpr (!ALIGN_EPI) { if (wr == 0) PG8_BAR; }
    PG8_BAR;
    if constexpr (Epi::AFTER_DRAIN) { E.fused(acc, cur, wr, wc, fr, fq, lds, wid, lane); S.done(cur); }
#undef PG8_SA
#undef PG8_SB
#undef PG8_STAGE
#undef PG8_LDA
#undef PG8_LDB
#undef PG8_MMA
#undef PG8_WAIT_V
#undef PG8_WAIT_L
#undef PG8_BAR
#undef PG8_SCHED
}
}

#define GAS __attribute__((address_space(1)))
#define LAS __attribute__((address_space(3)))
typedef unsigned short bf16;
typedef unsigned v4u __attribute__((ext_vector_type(4)));
typedef unsigned v2u __attribute__((ext_vector_type(2)));
typedef float f32x4 __attribute__((ext_vector_type(4)));
typedef float f32x16 __attribute__((ext_vector_type(16)));
typedef short bf16x8 __attribute__((ext_vector_type(8)));

constexpr int D = 1024, SEQ = 8192, CTXL = 256, RL = 16384, RC = 512, R = RL + RC, FF = 2816, NUP = 2 * FF;
constexpr int PJ = 3584;
constexpr int DIN = 6656, NGATE = 3072;
constexpr int COL_U = 0, COL_K = 512, COL_V = 1024, COL_Q = 1536, COL_Z = 2048, COL_B = 2560, COL_C = 3072;
constexpr int TOKP = SEQ + CTXL;
constexpr int NMODV = 9 * D;
constexpr float LN_EPS = 1e-5f;
constexpr float ALPHA = 1.4142135623730951f;
constexpr int NCH = 66;
constexpr int NWAVES = 8;

constexpr size_t KiB = 1024, MiB = 1024 * 1024;
constexpr size_t WS_MODV = 0, MODV_ZERO_BYTES = 256 * KiB;
constexpr size_t WS_BAR = 221184;
constexpr size_t WS_LAM = 256 * KiB, WS_LAML = 320 * KiB;
constexpr size_t WS_PTRS = 384 * KiB;
constexpr size_t WS_BB = 1 * MiB;
constexpr size_t WS_CT = 2 * MiB;
constexpr size_t WS_E = 3 * MiB;
constexpr size_t WS_W = 8 * MiB;
constexpr size_t WB_UP = (size_t)NUP * D * 2, WB_DN = (size_t)D * FF * 2, WB_IN = (size_t)DIN * D * 2, WB_G = (size_t)(512 + 3072) * 512 * 2, WB_OUT = (size_t)D * D * 2;
constexpr size_t WO_UP0 = 0, WO_UP1 = WB_UP, WO_DN0 = 2 * WB_UP, WO_DN1 = WO_DN0 + WB_DN, WO_IN = WO_DN1 + WB_DN, WO_G = WO_IN + WB_IN, WO_OUT = WO_G + WB_G, WL_BYTES = WO_OUT + WB_OUT;
constexpr size_t WS_XC = WS_W + 2 * WL_BYTES;
constexpr size_t WS_A = WS_XC + (size_t)RC * D * 4;
constexpr size_t WS_Y3 = WS_A + (size_t)R * PJ * 2;
constexpr size_t WS_H = WS_Y3 + (size_t)3 * R * 512 * 2;
constexpr size_t WS_VT = WS_H + (size_t)R * D * 2;
constexpr size_t WS_END = WS_VT + (size_t)R * 512 * 2;
static_assert(WS_E + (size_t)2 * 32 * NCH * 2 * 64 * 2 * 4 <= WS_W, "E fits");
static_assert((size_t)2 * 3 * 9 * 1024 * 4 <= WS_BAR && WS_BAR + 3456 * 4 <= MODV_ZERO_BYTES, "barrier words inside the zeroed region");
static_assert(WS_W % 256 == 0 && WL_BYTES % 256 == 0 && WS_A % 256 == 0 && WS_Y3 % 256 == 0 && WS_H % 256 == 0 && WS_VT % 256 == 0, "alignment");

constexpr int LDS_BYTES = 131072 + 16384;

__device__ __forceinline__ unsigned f2bf(float f) { unsigned u = __builtin_bit_cast(unsigned, f); return (u + 0x7fffu + ((u >> 16) & 1u)) >> 16; }
__device__ __forceinline__ unsigned pk2(float lo, float hi) { return pg8::cvt_pk_bf16(lo, hi); }
__device__ __forceinline__ float bf2f(unsigned short b) { return __builtin_bit_cast(float, (unsigned)b << 16); }
__device__ __forceinline__ float bflo(unsigned w) { return __builtin_bit_cast(float, w << 16); }
__device__ __forceinline__ float bfhi(unsigned w) { return __builtin_bit_cast(float, w & 0xffff0000u); }
__device__ __forceinline__ float sigmoidf_(float x) { return __builtin_amdgcn_rcpf(1.0f + __expf(-x)); }
__device__ __forceinline__ float siluf_(float x) { return x * sigmoidf_(x); }
__device__ __forceinline__ float gelu_tanh(float x) { const float u = 0.7978845608028654f * (x + 0.044715f * x * x * x); return x * sigmoidf_(2.0f * u); }
__device__ __forceinline__ float wave_sum(float v) {
#pragma unroll
    for (int o = 1; o < 64; o <<= 1) v += __shfl_xor(v, o);
    return v;
}
__device__ __forceinline__ int mid_of_row(int row) { return row < RL ? (row >> 13) : 2; }

using pg8::Unit;
struct EpiSwiglu {
    static constexpr bool PERM = true, AFTER_DRAIN = false;
    bf16* O;
    __device__ __forceinline__ void operator()(const f32x4 (&acc)[2][2][4][2], const Unit& u, int wr, int wc, int fr, int fq) const {
        const int row0 = u.pm * 256 + wr * 64 + fr, col0 = u.pn * 128 + wc * 32 + 8 * fq;
#pragma unroll
        for (int ai = 0; ai < 2; ++ai)
#pragma unroll
            for (int m = 0; m < 4; ++m) {
                bf16* rowp = O + (size_t)(row0 + ai * 128 + m * 16) * FF + col0;
                const f32x4 g0 = acc[ai][0][m][0], g1 = acc[ai][0][m][1], u0 = acc[ai][1][m][0], u1 = acc[ai][1][m][1];
                v4u w;
                w.x = pk2(siluf_(g0[0]) * u0[0], siluf_(g0[1]) * u0[1]); w.y = pk2(siluf_(g0[2]) * u0[2], siluf_(g0[3]) * u0[3]);
                w.z = pk2(siluf_(g1[0]) * u1[0], siluf_(g1[1]) * u1[1]); w.w = pk2(siluf_(g1[2]) * u1[2], siluf_(g1[3]) * u1[3]);
                *(v4u*)rowp = w;
            }
    }
};
struct EpiRes {
    static constexpr bool PERM = false, AFTER_DRAIN = false;
    const float* xin_lat; const float* xin_ctx; float* xout_lat; float* xout_ctx; const float* gate  ; float coef;
    __device__ __forceinline__ void operator()(const f32x4 (&acc)[2][2][4][2], const Unit& u, int wr, int wc, int fr, int fq) const {
        const bool lat = u.pm < 64;
        const float* xin = lat ? xin_lat + (size_t)u.pm * 256 * D : xin_ctx + (size_t)(u.pm - 64) * 256 * D;
        float* xout = lat ? xout_lat + (size_t)u.pm * 256 * D : xout_ctx + (size_t)(u.pm - 64) * 256 * D;
        const int mid = lat ? (u.pm >> 5) : 2;
        const int col0 = u.pn * 256 + wc * 32 + 4 * fq;
        const float* gp = gate + (size_t)mid * NMODV + col0;
#pragma unroll
        for (int bj = 0; bj < 2; ++bj)
#pragma unroll
            for (int n = 0; n < 2; ++n) {
                const f32x4 gv = *(const f32x4*)(gp + bj * 128 + n * 16) * coef;
#pragma unroll
                for (int ai = 0; ai < 2; ++ai)
#pragma unroll
                    for (int m = 0; m < 4; ++m) {
                        const size_t off = (size_t)(ai * 128 + wr * 64 + m * 16 + fr) * D + col0 + bj * 128 + n * 16;
                        const f32x4 xi = *(const f32x4*)(xin + off);
                        *(f32x4*)(xout + off) = xi * ALPHA + gv * acc[ai][bj][m][n];
                        asm volatile("" ::: "memory");
                    }
            }
    }
};
struct EpiProj {
    static constexpr bool PERM = true, AFTER_DRAIN = false;
    bf16* P; bf16* VT;
    __device__ __forceinline__ void operator()(const f32x4 (&acc)[2][2][4][2], const Unit& u, int wr, int wc, int fr, int fq) const {
        const int row0 = u.pm * 256 + wr * 64 + fr, col0 = u.pn * 256 + wc * 32 + 8 * fq;
        if (u.pn == 4 || u.pn == 5) {
#pragma unroll
            for (int ai = 0; ai < 2; ++ai)
#pragma unroll
                for (int m = 0; m < 4; ++m) {
                    const int row = row0 + ai * 128 + m * 16;
                    int b, tok; if (row < RL) { b = row >> 13; tok = row & 8191; } else { b = (row - RL) >> 8; tok = SEQ + ((row - RL) & 255); }
#pragma unroll
                    for (int bj = 0; bj < 2; ++bj)
#pragma unroll
                        for (int n = 0; n < 2; ++n)
#pragma unroll
                            for (int e = 0; e < 4; ++e) {
                                const int vc = col0 + bj * 128 + 4 * n + e - COL_V;
                                VT[((size_t)(b * 512 + vc)) * TOKP + tok] = (bf16)f2bf(acc[ai][bj][m][n][e]);
                            }
                }
        } else {
#pragma unroll
            for (int ai = 0; ai < 2; ++ai)
#pragma unroll
                for (int m = 0; m < 4; ++m) {
                    bf16* rowp = P + (size_t)(row0 + ai * 128 + m * 16) * PJ + col0;
#pragma unroll
                    for (int bj = 0; bj < 2; ++bj) {
                        const f32x4 v0 = acc[ai][bj][m][0], v1 = acc[ai][bj][m][1];
                        v4u w; w.x = pk2(v0[0], v0[1]); w.y = pk2(v0[2], v0[3]); w.z = pk2(v1[0], v1[1]); w.w = pk2(v1[2], v1[3]);
                        *(v4u*)(rowp + bj * 128) = w;
                    }
                }
        }
    }
};
struct EpiGates {
    static constexpr bool PERM = true, AFTER_DRAIN = false;
    bf16* P;
    __device__ __forceinline__ void operator()(const f32x4 (&acc)[2][2][4][2], const Unit& u, int wr, int wc, int fr, int fq) const {
        const int row0 = u.pm * 256 + wr * 64 + fr, col0 = 512 + u.pn * 256 + wc * 32 + 8 * fq;
#pragma unroll
        for (int ai = 0; ai < 2; ++ai)
#pragma unroll
            for (int m = 0; m < 4; ++m) {
                bf16* rowp = P + (size_t)(row0 + ai * 128 + m * 16) * PJ + col0;
#pragma unroll
                for (int bj = 0; bj < 2; ++bj) {
                    const f32x4 v0 = acc[ai][bj][m][0], v1 = acc[ai][bj][m][1];
                    v4u w; w.x = pk2(sigmoidf_(v0[0]), sigmoidf_(v0[1])); w.y = pk2(sigmoidf_(v0[2]), sigmoidf_(v0[3]));
                    w.z = pk2(sigmoidf_(v1[0]), sigmoidf_(v1[1])); w.w = pk2(sigmoidf_(v1[2]), sigmoidf_(v1[3]));
                    *(v4u*)(rowp + bj * 128) = w;
                }
            }
    }
};
struct EpiGlu {
    static constexpr bool PERM = true, AFTER_DRAIN = false;
    const bf16* GA; bf16* YA;
    __device__ __forceinline__ void operator()(const f32x4 (&acc)[2][2][4][2], const Unit& u, int wr, int wc, int fr, int fq) const {
        const int row0 = u.pm * 256 + wr * 64 + fr, col0 = u.pn * 256 + wc * 32 + 8 * fq;
#pragma unroll
        for (int ai = 0; ai < 2; ++ai)
#pragma unroll
            for (int m = 0; m < 4; ++m) {
                const size_t ro = (size_t)(row0 + ai * 128 + m * 16) * 512 + col0;
#pragma unroll
                for (int bj = 0; bj < 2; ++bj) {
                    const v4u gin = *(const v4u*)(GA + ro + bj * 128);
                    const f32x4 v0 = acc[ai][bj][m][0], v1 = acc[ai][bj][m][1];
                    v4u w;
                    w.x = pk2(bflo(gin.x) * sigmoidf_(v0[0]), bfhi(gin.x) * sigmoidf_(v0[1])); w.y = pk2(bflo(gin.y) * sigmoidf_(v0[2]), bfhi(gin.y) * sigmoidf_(v0[3]));
                    w.z = pk2(bflo(gin.z) * sigmoidf_(v1[0]), bfhi(gin.z) * sigmoidf_(v1[1])); w.w = pk2(bflo(gin.w) * sigmoidf_(v1[2]), bfhi(gin.w) * sigmoidf_(v1[3]));
                    *(v4u*)(YA + ro + bj * 128) = w;
                }
                asm volatile("" ::: "memory");
            }
    }
};
struct EpiBranch {
    static constexpr bool PERM = true, AFTER_DRAIN = false;
    const bf16* P; bf16* MM;
    __device__ __forceinline__ void operator()(const f32x4 (&acc)[2][2][4][2], const Unit& u, int wr, int wc, int fr, int fq) const {
        const int b = u.pn >> 2, pn = u.pn & 3, pm = u.pm - 66 * b;
        const int row0 = pm * 256 + wr * 64 + fr, col0 = pn * 256 + wc * 32 + 8 * fq;
#pragma unroll
        for (int ai = 0; ai < 2; ++ai)
#pragma unroll
            for (int m = 0; m < 4; ++m) {
                const int row = row0 + ai * 128 + m * 16;
                const bf16* gp = P + (size_t)row * PJ + 512 + b * 1024 + col0;
                bf16* mp = MM + (size_t)row * D + col0;
#pragma unroll
                for (int bj = 0; bj < 2; ++bj) {
                    const v4u gin = *(const v4u*)(gp + bj * 128);
                    const f32x4 v0 = acc[ai][bj][m][0], v1 = acc[ai][bj][m][1];
                    float o[8] = {bflo(gin.x) * v0[0], bfhi(gin.x) * v0[1], bflo(gin.y) * v0[2], bfhi(gin.y) * v0[3], bflo(gin.z) * v1[0], bfhi(gin.z) * v1[1], bflo(gin.w) * v1[2], bfhi(gin.w) * v1[3]};
                    if (b != 0) {
                        const unsigned long long* mq = (const unsigned long long*)(mp + bj * 128);
                        const unsigned long long q0 = __hip_atomic_load(mq, __ATOMIC_RELAXED, __HIP_MEMORY_SCOPE_AGENT), q1 = __hip_atomic_load(mq + 1, __ATOMIC_RELAXED, __HIP_MEMORY_SCOPE_AGENT);
                        v4u pv; pv.x = (unsigned)q0; pv.y = (unsigned)(q0 >> 32); pv.z = (unsigned)q1; pv.w = (unsigned)(q1 >> 32);
                        o[0] += bflo(pv.x); o[1] += bfhi(pv.x); o[2] += bflo(pv.y); o[3] += bfhi(pv.y); o[4] += bflo(pv.z); o[5] += bfhi(pv.z); o[6] += bflo(pv.w); o[7] += bfhi(pv.w); }
                    v4u w; w.x = pk2(o[0], o[1]); w.y = pk2(o[2], o[3]); w.z = pk2(o[4], o[5]); w.w = pk2(o[6], o[7]);
                    *(v4u*)(mp + bj * 128) = w;
                }
                asm volatile("" ::: "memory");
            }
    }
};
struct BranchOrder {
    int G, c, ntile;
    __device__ bool next(int i, Unit& u) const {
        const int T = (i / 3) * G + c, b = i % 3; if (T >= ntile) return false;
        const int pm = T >> 2, pn = T & 3; u.pm = 66 * b + pm; u.pn = 4 * b + pn; return true;
    }
    __device__ __forceinline__ void a_ready(const Unit&) const {}
    __device__ __forceinline__ void done(const Unit&) const {}
};

__device__ __forceinline__ void transpose_item(const float* Wsrc  , int N, bf16* dst, int ldk, LAS float* scr, int lane) {
#pragma unroll 8
    for (int i = 0; i < 32; ++i) { const int kk = 2 * i + (lane >> 5); scr[kk * 33 + (lane & 31)] = Wsrc[(size_t)kk * N + (lane & 31)]; }
    asm volatile("s_waitcnt lgkmcnt(0)" ::: "memory");
    const int c = lane & 7;
#pragma unroll
    for (int j = 0; j < 4; ++j) { const int n = (lane >> 3) + 8 * j; const LAS float* s = scr + (8 * c) * 33 + n;
        v4u o; o.x = pk2(s[0 * 33], s[1 * 33]); o.y = pk2(s[2 * 33], s[3 * 33]); o.z = pk2(s[4 * 33], s[5 * 33]); o.w = pk2(s[6 * 33], s[7 * 33]);
        *(v4u*)(dst + (size_t)n * ldk + 8 * c) = o; }
    asm volatile("s_waitcnt lgkmcnt(0)" ::: "memory");
}

struct Args {
    const float* in[25]; float* out; unsigned char* ws;
};
struct Ctx {
    unsigned char* ws;
    __device__ __forceinline__ const float* in(int i) const { return ((const float* const*)(ws + WS_PTRS))[i]; }
    __device__ __forceinline__ float* out() const { return ((float* const*)(ws + WS_PTRS))[25]; }
};

constexpr int IT_UP = 16 * 88, IT_DN = 44 * 32, IT_IN = 16 * 208, IT_GLU = 8 * 16, IT_BR = 8 * 32, IT_OUT = 16 * 32;
constexpr int IT_LAYER = 4 * IT_UP + 2 * IT_DN + IT_IN + IT_GLU + 3 * IT_BR + IT_OUT;

__device__ __forceinline__ void convert_item(const Args& a, int it, LAS float* scr, int lane) {
    const int l = it / IT_LAYER; int r = it % IT_LAYER;
    unsigned char* wl = a.ws + WS_W + (size_t)l * WL_BYTES;
    if (r < 4 * IT_UP) {
        const int which = r / IT_UP, s = which >> 1, isu = which & 1; r %= IT_UP;
        const int kb = r / 88, nb = r % 88, k0 = 64 * kb, n0 = 32 * nb;
        const float* src = a.in[isu ? 9 : 8] + ((size_t)(l * 2 + s) * D + k0) * FF + n0;
        bf16* dst = (bf16*)(wl + (s ? WO_UP1 : WO_UP0)) + (size_t)(256 * (n0 >> 7) + (n0 & 127) + 128 * isu) * D + k0;
        transpose_item(src, FF, dst, D, scr, lane); return;
    }
    r -= 4 * IT_UP;
    if (r < 2 * IT_DN) {
        const int s = r / IT_DN; r %= IT_DN;
        const int kb = r / 32, nb = r % 32, k0 = 64 * kb, n0 = 32 * nb;
        const float* src = a.in[10] + ((size_t)(l * 2 + s) * FF + k0) * D + n0;
        bf16* dst = (bf16*)(wl + (s ? WO_DN1 : WO_DN0)) + (size_t)n0 * FF + k0;
        transpose_item(src, D, dst, FF, scr, lane); return;
    }
    r -= 2 * IT_DN;
    if (r < IT_IN) {
        const int kb = r / 208, nb = r % 208, k0 = 64 * kb, n0 = 32 * nb;
        const float* src = a.in[11] + ((size_t)l * D + k0) * DIN + n0;
        bf16* dst = (bf16*)(wl + WO_IN) + (size_t)n0 * D + k0;
        transpose_item(src, DIN, dst, D, scr, lane); return;
    }
    r -= IT_IN;
    if (r < IT_GLU) {
        const int kb = r / 16, nb = r % 16, k0 = 64 * kb, n0 = 32 * nb;
        const float* src = a.in[20] + ((size_t)l * 512 + k0) * 512 + n0;
        bf16* dst = (bf16*)(wl + WO_G) + (size_t)n0 * 512 + k0;
        transpose_item(src, 512, dst, 512, scr, lane); return;
    }
    r -= IT_GLU;
    if (r < 3 * IT_BR) {
        const int b = r / IT_BR; r %= IT_BR;
        const int kb = r / 32, nb = r % 32, k0 = 64 * kb, n0 = 32 * nb;
        const float* src = a.in[23] + ((size_t)(l * 3 + b) * 512 + k0) * D + n0;
        bf16* dst = (bf16*)(wl + WO_G) + (size_t)(512 + b * 1024 + n0) * 512 + k0;
        transpose_item(src, D, dst, 512, scr, lane); return;
    }
    r -= 3 * IT_BR;
    {
        const int kb = r / 32, nb = r % 32, k0 = 64 * kb, n0 = 32 * nb;
        const float* src = a.in[24] + ((size_t)l * D + k0) * D + n0;
        bf16* dst = (bf16*)(wl + WO_OUT) + (size_t)n0 * D + k0;
        transpose_item(src, D, dst, D, scr, lane);
    }
}

__device__ __forceinline__ void s5_tables(const Args& a, int idx) {
    const int p = idx & 63, g = (idx >> 6) & 31, dir = (idx >> 11) & 1, l = idx >> 12;
    const int ldg = (l * 2 + dir) * 32 + g;
    const double lr = (double)a.in[12][ldg * 64 + p], li = (double)a.in[13][ldg * 64 + p];
    const double dt = exp((double)a.in[14][ldg]);
    const double mag = exp(lr * dt); double sn, cs; sincos(li * dt, &sn, &cs);
    const double ar = mag * cs, ai = mag * sn;
    float* lam = (float*)(a.ws + WS_LAM); float* lamL = (float*)(a.ws + WS_LAML);
    lam[(ldg * 64 + p) * 2] = (float)ar; lam[(ldg * 64 + p) * 2 + 1] = (float)ai;
    double pr = ar, pi = ai;
#pragma unroll
    for (int i = 0; i < 7; ++i) { const double nr = pr * pr - pi * pi, ni = 2.0 * pr * pi; pr = nr; pi = ni; }
    lamL[(ldg * 64 + p) * 2] = (float)pr; lamL[(ldg * 64 + p) * 2 + 1] = (float)pi;
    const double den = lr * lr + li * li, nr = ar - 1.0, ni = ai;
    const double cr = (nr * lr + ni * li) / den, ci = (ni * lr - nr * li) / den;
    bf16* BB = (bf16*)(a.ws + WS_BB);
    const float* bre = a.in[15] + ((size_t)ldg * 64 + p) * 16; const float* bim = a.in[16] + ((size_t)ldg * 64 + p) * 16;
#pragma unroll
    for (int i = 0; i < 16; ++i) {
        const double br = bre[i], bi = bim[i];
        BB[(((size_t)ldg * 2 + 0) * 64 + p) * 16 + i] = (bf16)f2bf((float)(cr * br - ci * bi));
        BB[(((size_t)ldg * 2 + 1) * 64 + p) * 16 + i] = (bf16)f2bf((float)(cr * bi + ci * br));
    }
    bf16* CT = (bf16*)(a.ws + WS_CT);
    const float* cre = a.in[17] + (size_t)ldg * 16 * 64; const float* cim = a.in[18] + (size_t)ldg * 16 * 64;
#pragma unroll
    for (int h = 0; h < 16; ++h) {
        CT[((size_t)ldg * 16 + h) * 128 + 2 * p] = (bf16)f2bf(cre[h * 64 + p]);
        CT[((size_t)ldg * 16 + h) * 128 + 2 * p + 1] = (bf16)f2bf(-cim[h * 64 + p]);
    }
}

__device__ __forceinline__ void mod_row(const float* xrow, const float* shift, const float* scale, bf16* hrow, int lane) {
    const f32x4* xr = (const f32x4*)xrow + lane; const f32x4* sh = (const f32x4*)shift + lane; const f32x4* sc = (const f32x4*)scale + lane;
    unsigned long long* o8 = (unsigned long long*)hrow + lane;
#pragma unroll
    for (int j = 0; j < 4; ++j) { const f32x4 v = xr[64 * j] * (sc[64 * j] + 1.0f) + sh[64 * j];
        o8[64 * j] = (unsigned long long)pk2(v[0], v[1]) | ((unsigned long long)pk2(v[2], v[3]) << 32); }
}
__device__ __forceinline__ void ln_row(float* xrow, const float* g, const float* b, const float* shift, const float* scale, bf16* hrow, int lane) {
    f32x4* xr = (f32x4*)xrow + lane;
    f32x4 v[4]; float s = 0.f;
#pragma unroll
    for (int j = 0; j < 4; ++j) { v[j] = xr[64 * j]; s += (v[j][0] + v[j][1]) + (v[j][2] + v[j][3]); }
    const float mean = wave_sum(s) * (1.f / D); float s2 = 0.f;
#pragma unroll
    for (int j = 0; j < 4; ++j) { v[j] = v[j] - mean; s2 += (v[j][0] * v[j][0] + v[j][1] * v[j][1]) + (v[j][2] * v[j][2] + v[j][3] * v[j][3]); }
    const float rstd = 1.f / sqrtf(wave_sum(s2) * (1.f / D) + LN_EPS);
    const f32x4* gg = (const f32x4*)g + lane; const f32x4* bb = (const f32x4*)b + lane;
#pragma unroll
    for (int j = 0; j < 4; ++j) { v[j] = v[j] * rstd * gg[64 * j] + bb[64 * j]; xr[64 * j] = v[j]; }
    if (hrow) {
        const f32x4* sh = (const f32x4*)shift + lane; const f32x4* sc = (const f32x4*)scale + lane;
        unsigned long long* o8 = (unsigned long long*)hrow + lane;
#pragma unroll
        for (int j = 0; j < 4; ++j) { const f32x4 w = v[j] * (sc[64 * j] + 1.0f) + sh[64 * j];
            o8[64 * j] = (unsigned long long)pk2(w[0], w[1]) | ((unsigned long long)pk2(w[2], w[3]) << 32); }
    }
}

#define MFMA32(a, b, c) __builtin_amdgcn_mfma_f32_32x32x16_bf16((a), (b), (c), 0, 0, 0)
#define MFMA16(a, b, c) __builtin_amdgcn_mfma_f32_16x16x32_bf16((a), (b), (c), 0, 0, 0)
constexpr int S5_ROWB = 272, S5_BATB = 16 * S5_ROWB, S5_WAVEB = 2 * S5_BATB;

template <bool PASS2>
__device__ __forceinline__ void s5_task(const Ctx& a, int l, int g, int ch, LAS unsigned char* wl, int lane) {
    const int j = lane & 31, hl = lane >> 5;
    const bf16* P = (const bf16*)(a.ws + WS_A);
    const float* LAM = (const float*)(a.ws + WS_LAM); const float* LAML = (const float*)(a.ws + WS_LAML);
    const bf16* BB = (const bf16*)(a.ws + WS_BB); const bf16* CT = (const bf16*)(a.ws + WS_CT);
    float* E = (float*)(a.ws + WS_E);
    const int rb0 = ch < 2 ? RL + 128 * ch : 128 * (ch - 2), rbstep = ch < 2 ? CTXL : SEQ;
    const int arow = rb0 + ((j >> 2) & 1) * rbstep + 4 * (j >> 3) + (j & 3);
    const bf16* ap = P + (size_t)arow * PJ + COL_U + g * 16 + 8 * hl;
    f32x4 yacc[8][2];
    if (PASS2) {
#pragma unroll
        for (int sb = 0; sb < 8; ++sb) { yacc[sb][0] = (f32x4){0.f, 0.f, 0.f, 0.f}; yacc[sb][1] = (f32x4){0.f, 0.f, 0.f, 0.f}; }
    }
    const f32x16 zero16 = {0.f, 0.f, 0.f, 0.f, 0.f, 0.f, 0.f, 0.f, 0.f, 0.f, 0.f, 0.f, 0.f, 0.f, 0.f, 0.f};
    bf16x8 ufa[8];
    if (PASS2) {
#pragma unroll
        for (int sb = 0; sb < 8; ++sb) ufa[sb] = *(const bf16x8*)(ap + (size_t)(16 * sb) * PJ);
    }
#pragma unroll
    for (int dir = 0; dir < 2; ++dir) {
        const int ldg = (l * 2 + dir) * 32 + g;
        float lr[2], li[2], sr[2], si[2];
#pragma unroll
        for (int ph = 0; ph < 2; ++ph) { lr[ph] = LAM[(ldg * 64 + j + 32 * ph) * 2]; li[ph] = LAM[(ldg * 64 + j + 32 * ph) * 2 + 1]; sr[ph] = 0.f; si[ph] = 0.f; }
        if (PASS2) {
            float Lr[2], Li[2];
#pragma unroll
            for (int ph = 0; ph < 2; ++ph) { Lr[ph] = LAML[(ldg * 64 + j + 32 * ph) * 2]; Li[ph] = LAML[(ldg * 64 + j + 32 * ph) * 2 + 1]; }
            const float* Eb = E + ((size_t)((dir * 32 + g) * NCH) * 2 + hl) * 128 + 2 * j;
            const int cnt = dir == 0 ? ch : (ch == 1 ? 0 : (ch == 0 ? 1 : 2 + (NCH - 1 - ch)));
            typedef float f32x2_t __attribute__((ext_vector_type(2)));
#pragma unroll 1
            for (int k0 = 0; k0 < cnt; k0 += 8) {
                f32x2_t ev[8][2];
#pragma unroll
                for (int q = 0; q < 8; ++q) { const int k = min(k0 + q, cnt - 1); const int cp = dir == 0 ? k : (k == 0 ? 1 : (k == 1 ? 0 : NCH + 1 - k));
                    ev[q][0] = *(const f32x2_t*)(Eb + (size_t)cp * 256); ev[q][1] = *(const f32x2_t*)(Eb + (size_t)cp * 256 + 64); }
#pragma unroll
                for (int q = 0; q < 8; ++q) if (k0 + q < cnt) {
#pragma unroll
                    for (int ph = 0; ph < 2; ++ph) { const float nr = Lr[ph] * sr[ph] - Li[ph] * si[ph] + ev[q][ph][0], ni = Lr[ph] * si[ph] + Li[ph] * sr[ph] + ev[q][ph][1]; sr[ph] = nr; si[ph] = ni; }
                }
            }
        }
        bf16x8 bfr[2][2];
#pragma unroll
        for (int ph = 0; ph < 2; ++ph)
#pragma unroll
            for (int ri = 0; ri < 2; ++ri) bfr[ph][ri] = *(const bf16x8*)(BB + (((size_t)ldg * 2 + ri) * 64 + j + 32 * ph) * 16 + 8 * hl);
        bf16x8 cfr[4];
        if (PASS2) {
#pragma unroll
            for (int ks = 0; ks < 4; ++ks) cfr[ks] = *(const bf16x8*)(CT + ((size_t)ldg * 16 + (lane & 15)) * 128 + 32 * ks + 8 * (lane >> 4));
        }
#pragma unroll
        for (int q = 0; q < (PASS2 ? 8 : 1); ++q)
#pragma unroll 1
        for (int q1 = 0; q1 < (PASS2 ? 1 : 8); ++q1) {
            const int sb = dir ? 7 - (q + q1) : (q + q1);
            bf16x8 uf;
            if (PASS2) uf = ufa[q]; else { const bf16* apq = ap; asm volatile("" : "+v"(apq)); uf = *(const bf16x8*)(apq + (size_t)(16 * sb) * PJ); }
            if (PASS2 && dir) uf = ufa[7 - q];
            f32x16 bu[2][2];
#pragma unroll
            for (int ph = 0; ph < 2; ++ph)
#pragma unroll
                for (int ri = 0; ri < 2; ++ri) bu[ph][ri] = MFMA32(uf, bfr[ph][ri], zero16);
#pragma unroll
            for (int rq = 0; rq < 16; ++rq) {
                const int r = dir ? 15 - rq : rq;
#pragma unroll
                for (int ph = 0; ph < 2; ++ph) {
                    const float nr = lr[ph] * sr[ph] - li[ph] * si[ph] + bu[ph][0][r], ni = lr[ph] * si[ph] + li[ph] * sr[ph] + bu[ph][1][r];
                    sr[ph] = nr; si[ph] = ni;
                    if (PASS2) *(LAS unsigned*)(wl + hl * S5_BATB + r * S5_ROWB + (j + 32 * ph) * 4) = pk2(nr, ni);
                }
            }
            if (PASS2) {
                asm volatile("s_waitcnt lgkmcnt(0)" ::: "memory");
#pragma unroll
                for (int bb = 0; bb < 2; ++bb)
#pragma unroll
                    for (int ks = 0; ks < 4; ++ks) {
                        const bf16x8 af = *(const LAS bf16x8*)(wl + bb * S5_BATB + (lane & 15) * S5_ROWB + (32 * ks + 8 * (lane >> 4)) * 2);
                        yacc[sb][bb] = MFMA16(af, cfr[ks], yacc[sb][bb]);
                    }
                asm volatile("s_waitcnt lgkmcnt(0)" ::: "memory");
            }
        }
        if (!PASS2) {
            float* e_ = E + ((size_t)((dir * 32 + g) * NCH + ch) * 2 + hl) * 128 + 2 * j;
#pragma unroll
            for (int ph = 0; ph < 2; ++ph) { e_[64 * ph] = sr[ph]; e_[64 * ph + 1] = si[ph]; }
        }
    }
    if (PASS2) {
        const int h = lane & 15, fq = lane >> 4;
        const float dv = a.in(19)[l * 512 + g * 16 + h];
        bf16* GA = (bf16*)(a.ws + WS_VT);
#pragma unroll
        for (int sb = 0; sb < 8; ++sb)
#pragma unroll
            for (int bb = 0; bb < 2; ++bb)
#pragma unroll
                for (int e = 0; e < 4; ++e) {
                    const int row = rb0 + bb * rbstep + 16 * sb + 4 * fq + e;
                    const float uu = bf2f(P[(size_t)row * PJ + COL_U + g * 16 + h]);
                    GA[(size_t)row * 512 + g * 16 + h] = (bf16)f2bf(gelu_tanh(yacc[sb][bb][e] + dv * uu));
                }
    }
}

constexpr float LOG2E = 1.4426950408889634f;
__device__ __forceinline__ void attn_task(const Ctx& a, int kind, int b, int h, int r, int jq, const LAS float* rpb  , int lane) {
    const int j = lane & 31, hl = lane >> 5;
    const bf16* P = (const bf16*)(a.ws + WS_A);
    const bf16* VT = (const bf16*)(a.ws + WS_VT) + (size_t)(b * 8 + h) * 64 * TOKP;
    bf16* YB = (bf16*)(a.ws + WS_Y3) + (size_t)R * 512;
    const int c = 32 * jq + j;
    const int rowq = kind == 0 ? b * SEQ + r * 64 + c : RL + b * CTXL + 32 * jq + j;
    bf16x8 qf[4];
#pragma unroll
    for (int s = 0; s < 4; ++s) qf[s] = *(const bf16x8*)(P + (size_t)rowq * PJ + COL_Q + h * 64 + 16 * s + 8 * hl);
    const int ka = j >> 3, kk = 16 * (ka >> 1) + 8 * ((j >> 2) & 1) + 4 * (ka & 1) + (j & 3);
    const f32x16 zero16 = {0.f, 0.f, 0.f, 0.f, 0.f, 0.f, 0.f, 0.f, 0.f, 0.f, 0.f, 0.f, 0.f, 0.f, 0.f, 0.f};
    f32x16 o0 = zero16, o1 = zero16;
    float m = -1e30f, lsum = 0.f;
    const int rs = min(max(r - 4, 0), 120), cs = min(max(c - 8, 0), 48);
    const float SC = 0.125f * LOG2E;
    const int ntile = kind == 0 ? 20 : 8;
    for (int t = 0; t < ntile; ++t) {
        int krow, tok0, tok1;
        int kr0 = 0, kc0 = 0;
        const bool win = t >= 8;
        if (!win) { krow = RL + b * CTXL + 32 * t + kk; tok0 = SEQ + 32 * t + 8 * hl; tok1 = tok0 + 16; }
        else { const int w = t - 8, jr2 = w / 3, cb = jq + (w - 3 * jr2); kr0 = rs + 2 * jr2; kc0 = 16 * cb;
            krow = b * SEQ + (kr0 + (kk >> 4)) * 64 + kc0 + (kk & 15); tok0 = kr0 * 64 + kc0 + 8 * hl; tok1 = tok0 + 64; }
        const bf16* kp = P + (size_t)krow * PJ + COL_K + h * 64 + 8 * hl;
        bf16x8 kf[4];
#pragma unroll
        for (int s = 0; s < 4; ++s) kf[s] = *(const bf16x8*)(kp + 16 * s);
        bf16x8 vf[2][2];
#pragma unroll
        for (int dh = 0; dh < 2; ++dh) { vf[0][dh] = *(const bf16x8*)(VT + (size_t)(32 * dh + j) * TOKP + tok0); vf[1][dh] = *(const bf16x8*)(VT + (size_t)(32 * dh + j) * TOKP + tok1); }
        f32x16 p = zero16;
#pragma unroll
        for (int s = 0; s < 4; ++s) p = MFMA32(kf[s], qf[s], p);
        float mx = -1e30f;
        if (!win) {
#pragma unroll
            for (int rr = 0; rr < 16; ++rr) { p[rr] *= SC; mx = fmaxf(mx, p[rr]); }
        } else {
            const LAS float* rp = rpb + h * 465;
#pragma unroll
            for (int rr = 0; rr < 16; ++rr) {
                const int kc = kc0 + 8 * hl + (rr & 7), kr = kr0 + (rr >> 3);
                const bool valid = (kc >= cs) && (kc < cs + 16);
                const int dc = min(max(kc - c + 15, 0), 30);
                const float bias = rp[(kr - r + 7) * 31 + dc];
                const float sv = valid ? p[rr] * SC + bias : -1e30f;
                p[rr] = sv; mx = fmaxf(mx, sv);
            }
        }
        mx = fmaxf(mx, __shfl_xor(mx, 32));
        const float mnew = fmaxf(m, mx), al = __builtin_amdgcn_exp2f(m - mnew);
        m = mnew;
        float ps = 0.f;
#pragma unroll
        for (int rr = 0; rr < 16; ++rr) { p[rr] = __builtin_amdgcn_exp2f(p[rr] - mnew); ps += p[rr]; }
        lsum = lsum * al + ps;
#pragma unroll
        for (int rr = 0; rr < 16; ++rr) { o0[rr] *= al; o1[rr] *= al; }
        bf16x8 pf[2];
#pragma unroll
        for (int sl = 0; sl < 2; ++sl) { v4u w; w.x = pk2(p[8 * sl], p[8 * sl + 1]); w.y = pk2(p[8 * sl + 2], p[8 * sl + 3]); w.z = pk2(p[8 * sl + 4], p[8 * sl + 5]); w.w = pk2(p[8 * sl + 6], p[8 * sl + 7]);
            pf[sl] = __builtin_bit_cast(bf16x8, w); }
#pragma unroll
        for (int sl = 0; sl < 2; ++sl) { o0 = MFMA32(vf[sl][0], pf[sl], o0); o1 = MFMA32(vf[sl][1], pf[sl], o1); }
    }
    const float ltot = lsum + __shfl_xor(lsum, 32), inv = 1.0f / ltot;
    bf16* yp = YB + (size_t)rowq * 512 + h * 64 + 4 * hl;
#pragma unroll
    for (int gq = 0; gq < 4; ++gq) {
        v2u w0, w1;
        w0.x = pk2(o0[4 * gq] * inv, o0[4 * gq + 1] * inv); w0.y = pk2(o0[4 * gq + 2] * inv, o0[4 * gq + 3] * inv);
        w1.x = pk2(o1[4 * gq] * inv, o1[4 * gq + 1] * inv); w1.y = pk2(o1[4 * gq + 2] * inv, o1[4 * gq + 3] * inv);
        *(v2u*)(yp + 8 * gq) = w0; *(v2u*)(yp + 32 + 8 * gq) = w1;
    }
}

__device__ __forceinline__ void conv_item(const Ctx& a, int l, int item) {
    const int row = item >> 6, ch = (item & 63) * 8;
    const bf16* P = (const bf16*)(a.ws + WS_A);
    bf16* YC = (bf16*)(a.ws + WS_Y3) + (size_t)2 * R * 512;
    int t, T; if (row < RL) { t = row & 8191; T = SEQ; } else { t = (row - RL) & 255; T = CTXL; }
    const float* cw = a.in(22) + (size_t)l * 3 * 512 + ch;
    float y[8] = {0.f, 0.f, 0.f, 0.f, 0.f, 0.f, 0.f, 0.f};
#pragma unroll
    for (int i = 0; i < 3; ++i) {
        const int tt = t + i - 1; if (tt < 0 || tt >= T) continue;
        const bf16* rp = P + (size_t)(row + i - 1) * PJ + ch;
        const v4u z = *(const v4u*)(rp + COL_Z), cg_ = *(const v4u*)(rp + COL_C);
        const f32x4 w0 = *(const f32x4*)(cw + i * 512), w1 = *(const f32x4*)(cw + i * 512 + 4);
        y[0] += w0[0] * bflo(z.x) * bflo(cg_.x); y[1] += w0[1] * bfhi(z.x) * bfhi(cg_.x); y[2] += w0[2] * bflo(z.y) * bflo(cg_.y); y[3] += w0[3] * bfhi(z.y) * bfhi(cg_.y);
        y[4] += w1[0] * bflo(z.z) * bflo(cg_.z); y[5] += w1[1] * bfhi(z.z) * bfhi(cg_.z); y[6] += w1[2] * bflo(z.w) * bflo(cg_.w); y[7] += w1[3] * bfhi(z.w) * bfhi(cg_.w);
    }
    const v4u bg = *(const v4u*)(P + (size_t)row * PJ + COL_B + ch);
    v4u w; w.x = pk2(y[0] * bflo(bg.x), y[1] * bfhi(bg.x)); w.y = pk2(y[2] * bflo(bg.y), y[3] * bfhi(bg.y)); w.z = pk2(y[4] * bflo(bg.z), y[5] * bfhi(bg.z)); w.w = pk2(y[6] * bflo(bg.w), y[7] * bfhi(bg.w));
    *(v4u*)(YC + (size_t)row * 512 + ch) = w;
}

typedef GAS unsigned gu32;
#define XB_TMO      128
#define XB_XCNT(j)  (256  + 64 * (j))
#define XB_XSUB(j)  (1280 + 64 * (j))
#define XB_XGEN(j)  (2304 + 64 * (j))
#define XB_TOP      3328
#define XB_TOPGEN   3392
#define XCD_BAR_WORDS 3456
#define XB_SPIN_CAP (1u << 18)

__device__ __forceinline__ unsigned xb_ld(unsigned* p)              { return __hip_atomic_load(p, __ATOMIC_RELAXED, __HIP_MEMORY_SCOPE_AGENT); }
__device__ __forceinline__ unsigned xb_add(unsigned* p, unsigned v) { return __hip_atomic_fetch_add(p, v, __ATOMIC_RELAXED, __HIP_MEMORY_SCOPE_AGENT); }
__device__ __forceinline__ unsigned xb_xcc_id() { return (unsigned)__builtin_amdgcn_s_getreg((3 << 11) | 20) & 0xFu; }
#define XB_SPIN(cond, bar) do { unsigned _sp = 0; while (cond) { __builtin_amdgcn_s_sleep(1); \
    if ((++_sp & 255u) == 0u) { if (xb_ld(&(bar)[XB_TMO])) break; if (_sp > XB_SPIN_CAP) { atomicAdd(&(bar)[XB_TMO], 1u); break; } } } } while (0)

struct XcdBarrier {
    unsigned* bar; unsigned x;
    volatile LAS unsigned* st;
};

__device__ __forceinline__ XcdBarrier xcd_barrier_post(unsigned* bar, volatile LAS unsigned* st) {
    XcdBarrier b; b.bar = bar; b.x = xb_xcc_id(); b.st = st;
    if (threadIdx.x == 0) (void)xb_add(&bar[XB_XCNT(b.x)], 1u);
    return b;
}
__device__ __forceinline__ void xcd_barrier_complete(unsigned* bar, unsigned x, unsigned& nloc, unsigned& nx) {
    const unsigned G = gridDim.x * gridDim.y * gridDim.z;
    unsigned sum, cnt, mine, sp = 0u;
    for (;;) {
        sum = 0u; cnt = 0u; mine = 0u;
#pragma unroll
        for (unsigned j = 0; j < 16; ++j) { const unsigned c = xb_ld(&bar[XB_XCNT(j)]); sum += c; cnt += (c > 0u) ? 1u : 0u; mine = (j == x) ? c : mine; }
        if (sum == G) break;
        __builtin_amdgcn_s_sleep(1);
        if ((++sp & 255u) == 0u) { if (xb_ld(&bar[XB_TMO])) break; if (sp > XB_SPIN_CAP) { atomicAdd(&bar[XB_TMO], 1u); break; } }
    }
    nloc = mine > 0u ? mine : 1u; nx = cnt > 0u ? cnt : 1u;
}

__device__ __forceinline__ void xcd_barrier(const XcdBarrier& b) {
    asm volatile("s_waitcnt vmcnt(0)" ::: "memory");
    __syncthreads();
    if (threadIdx.x == 0) {
        unsigned* bar = b.bar;
        __builtin_amdgcn_s_waitcnt(0);
        unsigned nloc = b.st[0], nx = b.st[1];
        if (nloc == 0u) { xcd_barrier_complete(bar, b.x, nloc, nx); b.st[0] = nloc; b.st[1] = nx; }
        const unsigned old = xb_add(&bar[XB_XSUB(b.x)], 1u);
        const unsigned gen = old / nloc;
        if (old + 1u == (gen + 1u) * nloc) {
            __builtin_amdgcn_fence(__ATOMIC_RELEASE, "agent");
            asm volatile("s_waitcnt vmcnt(0)" ::: "memory");
            const unsigned og = xb_add(&bar[XB_TOP], 1u);
            const unsigned tg = og / nx;
            if (og + 1u == (tg + 1u) * nx) xb_add(&bar[XB_TOPGEN], 1u);
            else XB_SPIN(xb_ld(&bar[XB_TOPGEN]) == tg, bar);
            __builtin_amdgcn_fence(__ATOMIC_ACQUIRE, "agent");
            xb_add(&bar[XB_XGEN(b.x)], 1u);
            asm volatile("s_waitcnt vmcnt(0)" ::: "memory");
        } else {
            XB_SPIN(xb_ld(&bar[XB_XGEN(b.x)]) == gen, bar);
            __builtin_amdgcn_fence(__ATOMIC_ACQUIRE, "agent");
            asm volatile("s_waitcnt vmcnt(0)" ::: "memory");
        }
    }
    __syncthreads();
}

template <class Epi, class Sched>
__device__ __forceinline__ void run_gemm(LAS unsigned char* lds, const bf16* A, const bf16* Bt, int M, int N, int K, const Sched& S, const Epi& E) {
    pg8::Gemm g{A, Bt, M, N, K};
    pg8::gemm_phase<Epi, Sched, true, true>(lds, g, S, E);
}

__global__ void __launch_bounds__(NWAVES * 64, 2) fwd_megakernel(Args a) {
    extern __shared__ __attribute__((aligned(16))) unsigned char lds_raw[];
    LAS unsigned char* lds = (LAS unsigned char*)lds_raw;
    LAS float* misc = (LAS float*)(lds + 131072);
    cg::grid_group grid = cg::this_grid();
    int tid = threadIdx.x, lane = tid & 63; int wave = __builtin_amdgcn_readfirstlane(tid >> 6);
    int G = gridDim.x, bx = blockIdx.x;
    int gw = bx * NWAVES + wave, NGW = G * NWAVES, NGT = G * NWAVES * 64; int gt = bx * (NWAVES * 64) + tid;
    Ctx c; c.ws = a.ws;
    volatile LAS unsigned* xst = (volatile LAS unsigned*)(lds + 131072 + 16128);
    if (tid < 2) xst[tid] = 0u;
    __syncthreads();
    (void)xcd_barrier_post((unsigned*)(a.ws + WS_BAR), xst);
#define PHASE_OPAQUE() do { tid = threadIdx.x; asm volatile("" : "+v"(tid)); lane = tid & 63; { int b_ = blockIdx.x, g_ = gridDim.x; asm volatile("" : "+v"(b_), "+v"(g_)); bx = __builtin_amdgcn_readfirstlane(b_); G = __builtin_amdgcn_readfirstlane(g_); } \
        NGW = G * NWAVES; NGT = G * NWAVES * 64; gt = bx * (NWAVES * 64) + tid; wave = __builtin_amdgcn_readfirstlane(tid >> 6); gw = bx * NWAVES + wave; \
        unsigned lo_ = (unsigned)(uintptr_t)a.ws, hi_ = (unsigned)((uintptr_t)a.ws >> 32); asm volatile("" : "+v"(lo_), "+v"(hi_)); \
        lo_ = __builtin_amdgcn_readfirstlane(lo_); hi_ = __builtin_amdgcn_readfirstlane(hi_); c.ws = (unsigned char*)(((uintptr_t)hi_ << 32) | (uintptr_t)lo_); } while (0)
#define SYNC() do { XcdBarrier b_; b_.bar = (unsigned*)(c.ws + WS_BAR); b_.x = xb_xcc_id(); b_.st = (volatile LAS unsigned*)(lds + 131072 + 16128); xcd_barrier(b_); PHASE_OPAQUE(); } while (0)
#define SYNC_CG() do { asm volatile("s_waitcnt vmcnt(0)" ::: "memory"); __syncthreads(); \
        if (wave == 0) { __builtin_amdgcn_fence(__ATOMIC_RELEASE, "agent"); asm volatile("s_waitcnt vmcnt(0)" ::: "memory"); } \
        grid.sync(); \
        __builtin_amdgcn_fence(__ATOMIC_ACQUIRE, "agent"); asm volatile("s_waitcnt vmcnt(0)" ::: "memory"); __syncthreads(); \
        PHASE_OPAQUE(); } while (0)
#define WSP(T, off) ((T*)(c.ws + (off)))
#ifndef DBG_STOP
#define DBG_STOP -1
#endif
#define DBG(k, off, nelem) do { if (DBG_STOP == (k)) { if ((nelem) > 0) { const bf16* s_ = WSP(bf16, off); float* o_ = c.out(); \
        for (size_t i_ = (size_t)gt; i_ < (size_t)RL * D; i_ += (size_t)NGT) o_[i_] = bf2f(s_[i_ % (size_t)(nelem)]); } return; } } while (0)
#define XROW(row) ((row) < RL ? c.out() + (size_t)(row) * D : WSP(float, WS_XC) + (size_t)((row) - RL) * D)

    if (tid < 26) ((const float**)(a.ws + WS_PTRS))[tid] = tid < 25 ? a.in[tid] : (const float*)a.out;
    for (int i = tid; i < 3 * D; i += NWAVES * 64) { const int mid = i >> 10, k = i & 1023; const float cv = mid < 2 ? a.in[1][mid * D + k] : a.in[3][k]; misc[i] = cv / (1.0f + expf(-cv)); }
    __syncthreads();
    {
        float* modv = (float*)(a.ws + WS_MODV);
        for (int idx = gt; idx < 2 * 16 * NMODV; idx += NGT) {
            const int n = idx % NMODV, kc = (idx / NMODV) & 15, l = idx / (NMODV * 16);
            const float* w = a.in[4] + ((size_t)l * D + 64 * kc) * NMODV + n;
            float a0 = 0.f, a1 = 0.f, a2 = 0.f;
#pragma unroll 8
            for (int k = 0; k < 64; ++k) { const float wv = w[(size_t)k * NMODV]; a0 += misc[64 * kc + k] * wv; a1 += misc[D + 64 * kc + k] * wv; a2 += misc[2 * D + 64 * kc + k] * wv; }
            if (kc == 0) { const float bm = a.in[5][l * NMODV + n]; a0 += bm; a1 += bm; a2 += bm; }
            atomicAdd(modv + (size_t)(l * 3 + 0) * NMODV + n, a0); atomicAdd(modv + (size_t)(l * 3 + 1) * NMODV + n, a1); atomicAdd(modv + (size_t)(l * 3 + 2) * NMODV + n, a2);
        }
    }
    if (gt < 8192) s5_tables(a, gt);
    __syncthreads();
    {
        LAS float* scr = (LAS float*)(lds + wave * 16384);
        for (int it = gw; it < 2 * IT_LAYER; it += NGW) convert_item(a, it, scr, lane);
    }
    SYNC_CG();
    for (int row = gw; row < R; row += NGW) {
        const float* xrow = row < RL ? c.in(0) + (size_t)row * D : c.in(2) + (size_t)(row - RL) * D;
        const float* mv = WSP(float, WS_MODV) + (size_t)mid_of_row(row) * NMODV;
        mod_row(xrow, mv, mv + D, WSP(bf16, WS_H) + (size_t)row * D, lane);
    }
    SYNC();

    DBG(1, WS_H, (size_t)R * D);
    DBG(2, WS_W, (size_t)WL_BYTES / 2);
#pragma unroll 1
    for (int l = 0; l < 2; ++l) {
#define WL(off) ((const bf16*)(c.ws + WS_W + (size_t)l * WL_BYTES + (off)))
#define MVL (WSP(float, WS_MODV) + (size_t)l * 3 * NMODV)
        pg8::StaticOrder SO;
        const int RM = l == 0 ? R : RL;
        { SO.init(R, NUP, G, bx); EpiSwiglu E{WSP(bf16, WS_A)}; run_gemm(lds, WSP(bf16, WS_H), WL(WO_UP0), R, NUP, D, SO, E); }
        SYNC();
        DBG(10 + 100 * l, WS_A, (size_t)R * FF);
        { SO.init(R, D, G, bx); float* XL = c.out(); float* XC = WSP(float, WS_XC);
          EpiRes E{l == 0 ? c.in(0) : XL, l == 0 ? c.in(2) : XC, XL, XC, MVL + 2 * D, 0.5f}; run_gemm(lds, WSP(bf16, WS_A), WL(WO_DN0), R, D, FF, SO, E); }
        SYNC();
        DBG(11 + 100 * l, 0, 0);
        for (int row = gw; row < R; row += NGW) {
            const float* mv = MVL + (size_t)mid_of_row(row) * NMODV;
            ln_row(XROW(row), c.in(6) + (size_t)l * 3 * D, c.in(7) + (size_t)l * 3 * D, mv + 3 * D, mv + 4 * D, WSP(bf16, WS_H) + (size_t)row * D, lane);
        }
        SYNC();
        DBG(12 + 100 * l, WS_H, (size_t)R * D);
        { SO.init(R, PJ, G, bx); EpiProj E{WSP(bf16, WS_A), WSP(bf16, WS_VT)}; run_gemm(lds, WSP(bf16, WS_H), WL(WO_IN), R, PJ, D, SO, E); }
        SYNC();
        DBG(13 + 100 * l, WS_A, (size_t)R * PJ);
       DBG(14 + 100 * l, WS_VT, (size_t)R * 512);
        {
            const float* rpb = c.in(21) + (size_t)l * 8 * 465;
            for (int i = tid; i < 8 * 465; i += NWAVES * 64) misc[i] = rpb[i] * LOG2E;
            __syncthreads();
            const int natt = 4096 + (l == 0 ? 128 : 0);
            for (int u = gw; u < natt; u += NGW) {
                if (u < 4096) attn_task(c, 0, u >> 11, (u >> 8) & 7, (u >> 1) & 127, u & 1, misc, lane);
                else { const int v = u - 4096; attn_task(c, 1, v >> 6, (v >> 3) & 7, 0, v & 7, misc, lane); }
            }
            for (int t = NGW - 1 - gw; t < 32 * NCH; t += NGW) s5_task<false>(c, l, t / NCH, t % NCH, lds + wave * S5_WAVEB, lane);
            for (int item = gt; item < R * 64; item += NGT) conv_item(c, l, item);
        }
        SYNC();
        DBG(15 + 100 * l, WS_Y3 + (size_t)R * 512 * 2, (size_t)2 * R * 512);
        {
            for (int t = gw; t < 32 * NCH; t += NGW) s5_task<true>(c, l, t / NCH, t % NCH, lds + wave * S5_WAVEB, lane);
            asm volatile("s_waitcnt vmcnt(0) lgkmcnt(0)" ::: "memory");
            __syncthreads();
            PHASE_OPAQUE();
            SO.init(RM, NGATE, G, bx); EpiGates E{WSP(bf16, WS_A)}; run_gemm(lds, WSP(bf16, WS_H), WL(WO_IN) + (size_t)PJ * D, RM, NGATE, D, SO, E);
        }
        SYNC();
        DBG(16 + 100 * l, WS_VT, (size_t)R * 512);
        DBG(17 + 100 * l, WS_A, (size_t)R * PJ);
        { SO.init(RM, 512, G, bx); EpiGlu E{WSP(bf16, WS_VT), WSP(bf16, WS_Y3)}; run_gemm(lds, WSP(bf16, WS_VT), WL(WO_G), RM, 512, 512, SO, E); }
        SYNC();
        DBG(18 + 100 * l, WS_Y3, (size_t)R * 512);
        { BranchOrder BO{G, bx, RM / 64}; EpiBranch E{WSP(bf16, WS_A), WSP(bf16, WS_H)}; run_gemm(lds, WSP(bf16, WS_Y3), WL(WO_G) + (size_t)512 * 512, 3 * R, 3072, 512, BO, E); }
        SYNC();
        DBG(19 + 100 * l, WS_H, (size_t)R * D);
        { SO.init(RM, D, G, bx); float* XL = c.out(); float* XC = WSP(float, WS_XC); EpiRes E{XL, XC, XL, XC, MVL + 5 * D, 1.0f}; run_gemm(lds, WSP(bf16, WS_H), WL(WO_OUT), RM, D, D, SO, E); }
        SYNC();
        DBG(20 + 100 * l, 0, 0);
        for (int row = gw; row < RM; row += NGW) {
            const float* mv = MVL + (size_t)mid_of_row(row) * NMODV;
            ln_row(XROW(row), c.in(6) + (size_t)(l * 3 + 1) * D, c.in(7) + (size_t)(l * 3 + 1) * D, mv + 6 * D, mv + 7 * D, WSP(bf16, WS_H) + (size_t)row * D, lane);
        }
        SYNC();
        DBG(21 + 100 * l, 0, 0);
        { SO.init(RM, NUP, G, bx); EpiSwiglu E{WSP(bf16, WS_A)}; run_gemm(lds, WSP(bf16, WS_H), WL(WO_UP1), RM, NUP, D, SO, E); }
        SYNC();
        { SO.init(RM, D, G, bx); float* XL = c.out(); float* XC = WSP(float, WS_XC); EpiRes E{XL, XC, XL, XC, MVL + 8 * D, 0.5f}; run_gemm(lds, WSP(bf16, WS_A), WL(WO_DN1), RM, D, FF, SO, E); }
        SYNC();
        for (int row = gw; row < RM; row += NGW) {
            const float* mv = MVL + 3 * NMODV + (size_t)mid_of_row(row) * NMODV;
            ln_row(XROW(row), c.in(6) + (size_t)(l * 3 + 2) * D, c.in(7) + (size_t)(l * 3 + 2) * D, mv, mv + D, l == 0 ? WSP(bf16, WS_H) + (size_t)row * D : (bf16*)nullptr, lane);
        }
        if (l == 0) SYNC();
    }
}

extern "C" void kernel_launch(void* const* d_in, const int* in_sizes, int n_in, void* d_out, int out_size, void* d_ws, size_t ws_size, hipStream_t stream) {
    static int grid = 0;
    if (grid == 0) {
        if (n_in != 25 || in_sizes[0] != RL * D || out_size != RL * D || ws_size < WS_END) {
            fprintf(stderr, "kernel_launch: unexpected shapes (n_in %d, in0 %d, out %d, ws %zu, need %zu); nothing launched\n", n_in, n_in > 0 ? in_sizes[0] : -1, out_size, ws_size, (size_t)WS_END); grid = -1; return; }
        int dev = 0, cus = 0, per_cu = 0;
        if (hipGetDevice(&dev) != hipSuccess || hipDeviceGetAttribute(&cus, hipDeviceAttributeMultiprocessorCount, dev) != hipSuccess) { grid = -1; return; }
        if (hipFuncSetAttribute((const void*)fwd_megakernel, hipFuncAttributeMaxDynamicSharedMemorySize, LDS_BYTES) != hipSuccess) { fprintf(stderr, "kernel_launch: hipFuncSetAttribute failed\n"); grid = -1; return; }
        if (hipOccupancyMaxActiveBlocksPerMultiprocessor(&per_cu, (const void*)fwd_megakernel, NWAVES * 64, LDS_BYTES) != hipSuccess || per_cu < 1) { fprintf(stderr, "kernel_launch: occupancy query says %d\n", per_cu); grid = -1; return; }
        grid = cus;
    }
    if (grid < 0) return;
    (void)hipMemsetAsync((char*)d_ws + WS_MODV, 0, MODV_ZERO_BYTES, stream);
    Args a{};
    for (int i = 0; i < 25; ++i) a.in[i] = (const float*)d_in[i];
    a.out = (float*)d_out; a.ws = (unsigned char*)d_ws;
    void* args[] = {&a};
    const hipError_t e = hipLaunchCooperativeKernel((const void*)fwd_megakernel, dim3(grid), dim3(NWAVES * 64), args, LDS_BYTES, stream);
    if (e != hipSuccess) fprintf(stderr, "kernel_launch: cooperative launch failed: %s (grid %d)\n", hipGetErrorString(e), grid);
}
```

```cpp
#include <hip/hip_runtime.h>
#include <hip/hip_cooperative_groups.h>
#include <cstdio>
#include <cstdint>
namespace cg = cooperative_groups;

namespace pg8 {
#define PG8_LAS __attribute__((address_space(3)))
typedef unsigned short bf16_t;
typedef short bf16x8 __attribute__((ext_vector_type(8)));
typedef float f32x4 __attribute__((ext_vector_type(4)));
typedef unsigned u32x4 __attribute__((ext_vector_type(4)));
constexpr int BM = 256, BK = 64, HALF = 128, HTB = HALF * BK * 2  , STAGE_BYTES = 8 * HTB, NXCD = 8, WGM = 8;

__host__ __device__ __forceinline__ int lds_byte(int r, int c) { const int st = (r >> 4) * 2 + (c >> 5), rr = r & 15, cc = c & 31, ob = rr * 64 + cc * 2; return st * 1024 + (ob ^ (((ob >> 9) & 1) << 5)); }
__host__ __device__ __forceinline__ void stage_rc(int b, int& R, int& C) { const int st = b / 1024, sb = b % 1024, swz = sb ^ (((sb >> 9) & 1) << 5); R = (st >> 1) * 16 + swz / 64; C = (st & 1) * 32 + (swz % 64) / 2; }
__host__ __device__ __forceinline__ int perm32(int rho) { const int n = rho >> 4, i = rho & 15; return 8 * (i >> 2) + 4 * n + (i & 3); }

struct Unit { int pm, pn, kofs; };
struct Gemm { const bf16_t* A; const bf16_t* Bt; int M, N, K, ld; };

struct StaticOrder {
    int nM, nN, nwg, G, c;
    __host__ __device__ void init(int M, int N, int G_, int c_) { nM = M / BM; nN = N / BM; nwg = nM * nN; G = G_; c = c_; }
    __host__ __device__ bool next(int i, Unit& u) const {
        const long L = (long)i * G + c; if (L >= nwg) return false;
        int wgid = (int)L; { const int q = nwg / NXCD, r = nwg % NXCD, xcd = wgid % NXCD, off = wgid / NXCD; wgid = (xcd < r ? xcd * (q + 1) : r * (q + 1) + (xcd - r) * q) + off; }
        const int nig = WGM * nN, gid = wgid / nig, fm = gid * WGM, gsz = (nM - fm) < WGM ? (nM - fm) : WGM;
        u.pm = fm + ((wgid % nig) % gsz); u.pn = (wgid % nig) / gsz; u.kofs = 0; return true;
    }
    __device__ __forceinline__ void a_ready(const Unit&) const {}
    __device__ __forceinline__ void done(const Unit&) const {}
};
typedef float f32x2_cv __attribute__((ext_vector_type(2))); typedef __bf16 bf16x2_cv __attribute__((ext_vector_type(2)));
__device__ __forceinline__ unsigned cvt_pk_bf16(float lo, float hi) { f32x2_cv v = {lo, hi}; bf16x2_cv b = __builtin_convertvector(v, bf16x2_cv); return __builtin_bit_cast(unsigned, b); }
template <class Epi, class Sched, bool ALIGN_EPI = false, bool SP2 = false>
__device__ __forceinline__ void gemm_phase(PG8_LAS unsigned char* lds, const Gemm g, const Sched& S, const Epi& E) {
    int tid_ = threadIdx.x; asm volatile("" : "+v"(tid_));
    const int tid = tid_, wid = __builtin_amdgcn_readfirstlane(tid >> 6), lane = tid & 63, wr = wid >> 2, wc = wid & 3, fr = lane & 15, fq = lane >> 4;
    const int K = g.K, nt = K / BK;
    unsigned voffA[2], voffB[2];
#pragma unroll
    for (int i = 0; i < 2; ++i) { int R, C; stage_rc(tid * 16 + i * 8192, R, C); const int Rb = Epi::PERM ? ((R & ~31) + perm32(R & 31)) : R;
        voffA[i] = (unsigned)(R * g.ld + C) * 2u; voffB[i] = (unsigned)(Rb * g.ld + C) * 2u; }
    const size_t kstep = (size_t)(BK * 2);
    const size_t hstep = (size_t)HALF * g.ld * 2;
    const size_t tstep = 2 * hstep;
    const unsigned ldsw = (unsigned)wid * 1024u;
    const int aoff = lds_byte(wr * 64 + fr, fq * 8), boff = lds_byte(wc * 32 + fr, fq * 8);
#define PG8_SA(b, h) (((b) * 2 + (h)) * HTB)
#define PG8_SB(b, h) ((4 + (b) * 2 + (h)) * HTB)
#define PG8_STAGE(bufoff, gbase, voff) do { _Pragma("unroll") for (int _i = 0; _i < 2; ++_i) \
        __builtin_amdgcn_global_load_lds((const unsigned*)((const char*)(gbase) + (voff)[_i]), (PG8_LAS unsigned*)(lds + (bufoff) + ldsw + _i * 8192), 16, 0, 0); } while (0)
#define PG8_LDA(dst, b, h) do { _Pragma("unroll") for (int m = 0; m < 4; ++m) _Pragma("unroll") for (int k = 0; k < 2; ++k) dst[m][k] = *(const PG8_LAS bf16x8*)(lds + PG8_SA(b, h) + aoff + m * 2048 + k * 1024); } while (0)
#define PG8_LDB(dst, b, h) do { _Pragma("unroll") for (int n = 0; n < 2; ++n) _Pragma("unroll") for (int k = 0; k < 2; ++k) dst[n][k] = *(const PG8_LAS bf16x8*)(lds + PG8_SB(b, h) + boff + n * 2048 + k * 1024); } while (0)
#define PG8_MMA(ai, bj, At, Bt) do { __builtin_amdgcn_s_setprio(1); _Pragma("unroll") for (int m = 0; m < 4; ++m) _Pragma("unroll") for (int n = 0; n < 2; ++n) _Pragma("unroll") for (int k = 0; k < 2; ++k) \
        acc[ai][bj][m][n] = __builtin_amdgcn_mfma_f32_16x16x32_bf16(Bt[n][k], At[m][k], acc[ai][bj][m][n], 0, 0, 0); __builtin_amdgcn_s_setprio(0); } while (0)
#define PG8_WAIT_V(n) asm volatile("s_waitcnt vmcnt(" #n ")" ::: "memory")
#define PG8_WAIT_L(n) asm volatile("s_waitcnt lgkmcnt(" #n ")" ::: "memory")
#define PG8_BAR __builtin_amdgcn_s_barrier()
#define PG8_SCHED __builtin_amdgcn_sched_barrier(0)
    Unit cur, nxt; int ui = 0;
    if (!S.next(0, cur)) return;
    f32x4 acc[2][2][4][2];
#pragma unroll
    for (int a = 0; a < 2; ++a)
#pragma unroll
        for (int b = 0; b < 2; ++b)
#pragma unroll
            for (int m = 0; m < 4; ++m)
#pragma unroll
                for (int n = 0; n < 2; ++n) acc[a][b][m][n] = (f32x4){0.f, 0.f, 0.f, 0.f};
    bf16x8 At[4][2], B0[2][2], B1[2][2];
    const char* cA = (const char*)g.A + (size_t)cur.pm * tstep + (size_t)cur.kofs * 2; const char* cB = (const char*)g.Bt + (size_t)cur.pn * tstep + (size_t)cur.kofs * 2;
    S.a_ready(cur);
    if constexpr (SP2) {
        PG8_STAGE(PG8_SB(0, 0), cB, voffB); PG8_STAGE(PG8_SB(0, 1), cB + hstep, voffB); PG8_STAGE(PG8_SA(0, 0), cA, voffA); PG8_STAGE(PG8_SA(0, 1), cA + hstep, voffA);
        if (wr == 1) PG8_BAR;
        PG8_WAIT_V(2); PG8_BAR;
        PG8_STAGE(PG8_SB(1, 0), cB + kstep, voffB); PG8_STAGE(PG8_SA(1, 0), cA + kstep, voffA); PG8_STAGE(PG8_SB(1, 1), cB + hstep + kstep, voffB);
        PG8_WAIT_V(6); PG8_BAR;
    } else {
        PG8_STAGE(PG8_SB(0, 0), cB, voffB); PG8_STAGE(PG8_SA(0, 0), cA, voffA); PG8_STAGE(PG8_SB(0, 1), cB + hstep, voffB); PG8_STAGE(PG8_SA(0, 1), cA + hstep, voffA);
        if (wr == 1) PG8_BAR;
        PG8_WAIT_V(4); PG8_BAR;
        PG8_STAGE(PG8_SB(1, 0), cB + kstep, voffB); PG8_STAGE(PG8_SA(1, 0), cA + kstep, voffA); PG8_STAGE(PG8_SB(1, 1), cB + hstep + kstep, voffB);
        PG8_WAIT_V(6); PG8_BAR;
    }
    for (;;) {
        const bool has_next = S.next(ui + 1, nxt);
        const char* nA = has_next ? (const char*)g.A + (size_t)nxt.pm * tstep + (size_t)nxt.kofs * 2 : cA; const char* nB = has_next ? (const char*)g.Bt + (size_t)nxt.pn * tstep + (size_t)nxt.kofs * 2 : cB;
        for (int t = 0; t < nt; t += 2) {
            const bool last = (t == nt - 2);
            const char* a1 = cA + (size_t)(t + 1) * kstep;
            const char* a2 = last ? nA : cA + (size_t)(t + 2) * kstep; const char* b2 = last ? nB : cB + (size_t)(t + 2) * kstep;
            const char* a3 = a2 + kstep; const char* b3 = b2 + kstep;
            if (last && has_next) S.a_ready(nxt);
            if constexpr (SP2) {
            PG8_LDB(B0, 0, 0); PG8_LDB(B1, 0, 1); PG8_SCHED; PG8_LDA(At, 0, 0); PG8_STAGE(PG8_SA(1, 1), a1 + hstep, voffA);
            PG8_WAIT_V(8); PG8_WAIT_L(0); PG8_BAR; PG8_MMA(0, 0, At, B0); PG8_MMA(0, 1, At, B1); PG8_BAR; PG8_SCHED;
            PG8_LDA(At, 0, 1); PG8_STAGE(PG8_SB(0, 0), b2, voffB); PG8_STAGE(PG8_SB(0, 1), b2 + hstep, voffB); PG8_STAGE(PG8_SA(0, 0), a2, voffA);
            PG8_WAIT_V(8); PG8_WAIT_L(0); PG8_BAR; PG8_MMA(1, 0, At, B0); PG8_MMA(1, 1, At, B1); PG8_BAR; PG8_SCHED;
            PG8_LDB(B0, 1, 0); PG8_LDB(B1, 1, 1); PG8_SCHED; PG8_LDA(At, 1, 0); PG8_STAGE(PG8_SA(0, 1), a2 + hstep, voffA);
            PG8_WAIT_V(8); PG8_WAIT_L(0); PG8_BAR; PG8_MMA(0, 0, At, B0); PG8_MMA(0, 1, At, B1); PG8_BAR; PG8_SCHED;
            PG8_LDA(At, 1, 1); PG8_STAGE(PG8_SB(1, 0), b3, voffB); PG8_STAGE(PG8_SB(1, 1), b3 + hstep, voffB); PG8_STAGE(PG8_SA(1, 0), a3, voffA);
            PG8_WAIT_V(8); PG8_WAIT_L(0); PG8_BAR; PG8_MMA(1, 0, At, B0); PG8_MMA(1, 1, At, B1); PG8_BAR; PG8_SCHED;
            } else {
            PG8_LDB(B0, 0, 0); PG8_SCHED; PG8_LDA(At, 0, 0); PG8_STAGE(PG8_SA(1, 1), a1 + hstep, voffA);
            PG8_WAIT_L(8); PG8_BAR; PG8_WAIT_L(0); PG8_MMA(0, 0, At, B0); PG8_BAR; PG8_SCHED;
            PG8_LDB(B1, 0, 1); PG8_STAGE(PG8_SB(0, 0), b2, voffB);
            PG8_BAR; PG8_WAIT_L(0); PG8_MMA(0, 1, At, B1); PG8_BAR;
            PG8_LDA(At, 0, 1); PG8_STAGE(PG8_SA(0, 0), a2, voffA);
            PG8_BAR; PG8_WAIT_L(0); PG8_MMA(1, 0, At, B0); PG8_BAR; PG8_SCHED;
            PG8_STAGE(PG8_SB(0, 1), b2 + hstep, voffB);
            PG8_WAIT_V(6); PG8_BAR; PG8_MMA(1, 1, At, B1); PG8_BAR;
            PG8_LDB(B0, 1, 0); PG8_SCHED; PG8_LDA(At, 1, 0); PG8_STAGE(PG8_SA(0, 1), a2 + hstep, voffA);
            PG8_WAIT_L(8); PG8_BAR; PG8_WAIT_L(0); PG8_MMA(0, 0, At, B0); PG8_BAR; PG8_SCHED;
            PG8_LDB(B1, 1, 1); PG8_STAGE(PG8_SB(1, 0), b3, voffB);
            PG8_BAR; PG8_WAIT_L(0); PG8_MMA(0, 1, At, B1); PG8_BAR;
            PG8_LDA(At, 1, 1); PG8_STAGE(PG8_SA(1, 0), a3, voffA);
            PG8_BAR; PG8_WAIT_L(0); PG8_MMA(1, 0, At, B0); PG8_BAR; PG8_SCHED;
            PG8_STAGE(PG8_SB(1, 1), b3 + hstep, voffB);
            PG8_WAIT_V(6); PG8_BAR; PG8_MMA(1, 1, At, B1); PG8_BAR;
            }
        }
        if constexpr (ALIGN_EPI) { if (wr == 0) PG8_BAR; }
        if constexpr (!Epi::AFTER_DRAIN) { E(acc, cur, wr, wc, fr, fq); S.done(cur); }
        if (!has_next) break;
#pragma unroll
        for (int a = 0; a < 2; ++a)
#pragma unroll
            for (int b = 0; b < 2; ++b)
#pragma unroll
                for (int m = 0; m < 4; ++m)
#pragma unroll
                    for (int n = 0; n < 2; ++n) acc[a][b][m][n] = (f32x4){0.f, 0.f, 0.f, 0.f};
        cur = nxt; cA = nA; cB = nB; ++ui;
        if constexpr (ALIGN_EPI) { if (wr == 1) PG8_BAR; }
    }
    PG8_WAIT_V(0);
    if constexpr (!ALIGN_EPI) { if (wr == 0) PG8_BAR; }
    PG8_BAR;
    if constexpr (Epi::AFTER_DRAIN) { E.fused(acc, cur, wr, wc, fr, fq, lds, wid, lane); S.done(cur); }
#undef PG8_SA
#undef PG8_SB
#undef PG8_STAGE
#undef PG8_LDA
#undef PG8_LDB
#undef PG8_MMA
#undef PG8_WAIT_V
#undef PG8_WAIT_L
#undef PG8_BAR
#undef PG8_SCHED
}
}

#define GAS __attribute__((address_space(1)))
#define LAS __attribute__((address_space(3)))
typedef unsigned short bf16;
typedef unsigned v4u __attribute__((ext_vector_type(4)));
typedef unsigned v2u __attribute__((ext_vector_type(2)));
typedef float f32x4 __attribute__((ext_vector_type(4)));
typedef float f32x16 __attribute__((ext_vector_type(16)));
typedef short bf16x8 __attribute__((ext_vector_type(8)));

constexpr int D = 1024, SEQ = 8192, CTXL = 256, RL = 16384, RC = 512, R = RL + RC, FF = 2816, NUP = 2 * FF;
constexpr int PJ = 3584;
constexpr int DIN = 6656, NGATE = 3072;
constexpr int COL_U = 0, COL_K = 512, COL_V = 1024, COL_Q = 1536, COL_Z = 2048, COL_B = 2560, COL_C = 3072;
constexpr int TOKP = SEQ + CTXL;
constexpr int NMODV = 9 * D;
constexpr float LN_EPS = 1e-5f;
constexpr float ALPHA = 1.4142135623730951f;
constexpr int NCH = 66;
constexpr int NWAVES = 8;

constexpr size_t KiB = 1024, MiB = 1024 * 1024;
constexpr size_t WS_MODV = 0, MODV_ZERO_BYTES = 256 * KiB;
constexpr size_t WS_BAR = 221184;
constexpr size_t WS_LAM = 256 * KiB, WS_LAML = 320 * KiB;
constexpr size_t WS_PTRS = 384 * KiB;
constexpr size_t WS_BB = 1 * MiB;
constexpr size_t WS_CT = 2 * MiB;
constexpr size_t WS_E = 3 * MiB;
constexpr size_t WS_W = 8 * MiB;
constexpr size_t WB_UP = (size_t)NUP * D * 2, WB_DN = (size_t)D * FF * 2, WB_IN = (size_t)DIN * D * 2, WB_G = (size_t)(512 + 3072) * 512 * 2, WB_OUT = (size_t)D * D * 2;
constexpr size_t WO_UP0 = 0, WO_UP1 = WB_UP, WO_DN0 = 2 * WB_UP, WO_DN1 = WO_DN0 + WB_DN, WO_IN = WO_DN1 + WB_DN, WO_G = WO_IN + WB_IN, WO_OUT = WO_G + WB_G, WL_BYTES = WO_OUT + WB_OUT;
constexpr size_t WS_XC = WS_W + 2 * WL_BYTES;
constexpr size_t WS_A = WS_XC + (size_t)RC * D * 4;
constexpr size_t WS_SLAB = WS_A + (size_t)R * FF * 2;
static_assert(WS_SLAB % 256 == 0 && WS_SLAB + (size_t)11 * RC * D * 4 <= WS_A + (size_t)R * PJ * 2, "slab fits behind ACT");
constexpr size_t WS_Y3 = WS_A + (size_t)R * PJ * 2;
constexpr size_t WS_H = WS_Y3 + (size_t)3 * R * 512 * 2;
constexpr size_t WS_VT = WS_H + (size_t)R * D * 2;
constexpr size_t WS_END = WS_VT + (size_t)R * 512 * 2;
static_assert(WS_E + (size_t)2 * 32 * NCH * 2 * 64 * 2 * 4 <= WS_W, "E fits");
static_assert((size_t)2 * 3 * 9 * 1024 * 4 <= WS_BAR && WS_BAR + 3456 * 4 <= MODV_ZERO_BYTES, "barrier words inside the zeroed region");
static_assert(WS_W % 256 == 0 && WL_BYTES % 256 == 0 && WS_A % 256 == 0 && WS_Y3 % 256 == 0 && WS_H % 256 == 0 && WS_VT % 256 == 0, "alignment");

constexpr int LDS_BYTES = 131072 + 16384;

__device__ __forceinline__ unsigned f2bf(float f) { unsigned u = __builtin_bit_cast(unsigned, f); return (u + 0x7fffu + ((u >> 16) & 1u)) >> 16; }
__device__ __forceinline__ unsigned pk2(float lo, float hi) { return pg8::cvt_pk_bf16(lo, hi); }
__device__ __forceinline__ float bf2f(unsigned short b) { return __builtin_bit_cast(float, (unsigned)b << 16); }
__device__ __forceinline__ float bflo(unsigned w) { return __builtin_bit_cast(float, w << 16); }
__device__ __forceinline__ float bfhi(unsigned w) { return __builtin_bit_cast(float, w & 0xffff0000u); }
__device__ __forceinline__ float sigmoidf_(float x) { return __builtin_amdgcn_rcpf(1.0f + __expf(-x)); }
__device__ __forceinline__ float siluf_(float x) { return x * sigmoidf_(x); }
__device__ __forceinline__ float gelu_tanh(float x) { const float u = 0.7978845608028654f * (x + 0.044715f * x * x * x); return x * sigmoidf_(2.0f * u); }
__device__ __forceinline__ float wave_sum(float v) {
#pragma unroll
    for (int o = 1; o < 64; o <<= 1) v += __shfl_xor(v, o);
    return v;
}
__device__ __forceinline__ int mid_of_row(int row) { return row < RL ? (row >> 13) : 2; }

using pg8::Unit;
struct EpiSwiglu {
    static constexpr bool PERM = true, AFTER_DRAIN = false;
    bf16* O;
    __device__ __forceinline__ void operator()(const f32x4 (&acc)[2][2][4][2], const Unit& u, int wr, int wc, int fr, int fq) const {
        const int row0 = u.pm * 256 + wr * 64 + fr, col0 = u.pn * 128 + wc * 32 + 8 * fq;
#pragma unroll
        for (int ai = 0; ai < 2; ++ai)
#pragma unroll
            for (int m = 0; m < 4; ++m) {
                bf16* rowp = O + (size_t)(row0 + ai * 128 + m * 16) * FF + col0;
                const f32x4 g0 = acc[ai][0][m][0], g1 = acc[ai][0][m][1], u0 = acc[ai][1][m][0], u1 = acc[ai][1][m][1];
                v4u w;
                w.x = pk2(siluf_(g0[0]) * u0[0], siluf_(g0[1]) * u0[1]); w.y = pk2(siluf_(g0[2]) * u0[2], siluf_(g0[3]) * u0[3]);
                w.z = pk2(siluf_(g1[0]) * u1[0], siluf_(g1[1]) * u1[1]); w.w = pk2(siluf_(g1[2]) * u1[2], siluf_(g1[3]) * u1[3]);
                *(v4u*)rowp = w;
            }
    }
};
struct EpiRes {
    static constexpr bool PERM = false, AFTER_DRAIN = false;
    const float* xin_lat; const float* xin_ctx; float* xout_lat; float* xout_ctx; const float* gate  ; float coef;
    __device__ __forceinline__ void operator()(const f32x4 (&acc)[2][2][4][2], const Unit& u, int wr, int wc, int fr, int fq) const {
        const bool lat = u.pm < 64;
        const float* xin = lat ? xin_lat + (size_t)u.pm * 256 * D : xin_ctx + (size_t)(u.pm - 64) * 256 * D;
        float* xout = lat ? xout_lat + (size_t)u.pm * 256 * D : xout_ctx + (size_t)(u.pm - 64) * 256 * D;
        const int mid = lat ? (u.pm >> 5) : 2;
        const int col0 = u.pn * 256 + wc * 32 + 4 * fq;
        const float* gp = gate + (size_t)mid * NMODV + col0;
#pragma unroll
        for (int bj = 0; bj < 2; ++bj)
#pragma unroll
            for (int n = 0; n < 2; ++n) {
                const f32x4 gv = *(const f32x4*)(gp + bj * 128 + n * 16) * coef;
#pragma unroll
                for (int ai = 0; ai < 2; ++ai)
#pragma unroll
                    for (int m = 0; m < 4; ++m) {
                        const size_t off = (size_t)(ai * 128 + wr * 64 + m * 16 + fr) * D + col0 + bj * 128 + n * 16;
                        const f32x4 xi = *(const f32x4*)(xin + off);
                        *(f32x4*)(xout + off) = xi * ALPHA + gv * acc[ai][bj][m][n];
                        asm volatile("" ::: "memory");
                    }
            }
    }
};
struct EpiProj {
    static constexpr bool PERM = true, AFTER_DRAIN = false;
    bf16* P; bf16* VT;
    __device__ __forceinline__ void operator()(const f32x4 (&acc)[2][2][4][2], const Unit& u, int wr, int wc, int fr, int fq) const {
        const int row0 = u.pm * 256 + wr * 64 + fr, col0 = u.pn * 256 + wc * 32 + 8 * fq;
        if (u.pn == 4 || u.pn == 5) {
#pragma unroll
            for (int ai = 0; ai < 2; ++ai)
#pragma unroll
                for (int m = 0; m < 4; ++m) {
                    const int row = row0 + ai * 128 + m * 16;
                    int b, tok; if (row < RL) { b = row >> 13; tok = row & 8191; } else { b = (row - RL) >> 8; tok = SEQ + ((row - RL) & 255); }
#pragma unroll
                    for (int bj = 0; bj < 2; ++bj)
#pragma unroll
                        for (int n = 0; n < 2; ++n)
#pragma unroll
                            for (int e = 0; e < 4; ++e) {
                                const int vc = col0 + bj * 128 + 4 * n + e - COL_V;
                                VT[((size_t)(b * 512 + vc)) * TOKP + tok] = (bf16)f2bf(acc[ai][bj][m][n][e]);
                            }
                }
        } else {
#pragma unroll
            for (int ai = 0; ai < 2; ++ai)
#pragma unroll
                for (int m = 0; m < 4; ++m) {
                    bf16* rowp = P + (size_t)(row0 + ai * 128 + m * 16) * PJ + col0;
#pragma unroll
                    for (int bj = 0; bj < 2; ++bj) {
                        const f32x4 v0 = acc[ai][bj][m][0], v1 = acc[ai][bj][m][1];
                        v4u w; w.x = pk2(v0[0], v0[1]); w.y = pk2(v0[2], v0[3]); w.z = pk2(v1[0], v1[1]); w.w = pk2(v1[2], v1[3]);
                        *(v4u*)(rowp + bj * 128) = w;
                    }
                }
        }
    }
};
struct EpiGates {
    static constexpr bool PERM = true, AFTER_DRAIN = false;
    bf16* P;
    __device__ __forceinline__ void operator()(const f32x4 (&acc)[2][2][4][2], const Unit& u, int wr, int wc, int fr, int fq) const {
        const int row0 = u.pm * 256 + wr * 64 + fr, col0 = 512 + u.pn * 256 + wc * 32 + 8 * fq;
#pragma unroll
        for (int ai = 0; ai < 2; ++ai)
#pragma unroll
            for (int m = 0; m < 4; ++m) {
                bf16* rowp = P + (size_t)(row0 + ai * 128 + m * 16) * PJ + col0;
#pragma unroll
                for (int bj = 0; bj < 2; ++bj) {
                    const f32x4 v0 = acc[ai][bj][m][0], v1 = acc[ai][bj][m][1];
                    v4u w; w.x = pk2(sigmoidf_(v0[0]), sigmoidf_(v0[1])); w.y = pk2(sigmoidf_(v0[2]), sigmoidf_(v0[3]));
                    w.z = pk2(sigmoidf_(v1[0]), sigmoidf_(v1[1])); w.w = pk2(sigmoidf_(v1[2]), sigmoidf_(v1[3]));
                    *(v4u*)(rowp + bj * 128) = w;
                }
            }
    }
};
struct EpiGlu {
    static constexpr bool PERM = true, AFTER_DRAIN = false;
    const bf16* GA; bf16* YA;
    __device__ __forceinline__ void operator()(const f32x4 (&acc)[2][2][4][2], const Unit& u, int wr, int wc, int fr, int fq) const {
        const int row0 = u.pm * 256 + wr * 64 + fr, col0 = u.pn * 256 + wc * 32 + 8 * fq;
#pragma unroll
        for (int ai = 0; ai < 2; ++ai)
#pragma unroll
            for (int m = 0; m < 4; ++m) {
                const size_t ro = (size_t)(row0 + ai * 128 + m * 16) * 512 + col0;
#pragma unroll
                for (int bj = 0; bj < 2; ++bj) {
                    const v4u gin = *(const v4u*)(GA + ro + bj * 128);
                    const f32x4 v0 = acc[ai][bj][m][0], v1 = acc[ai][bj][m][1];
                    v4u w;
                    w.x = pk2(bflo(gin.x) * sigmoidf_(v0[0]), bfhi(gin.x) * sigmoidf_(v0[1])); w.y = pk2(bflo(gin.y) * sigmoidf_(v0[2]), bfhi(gin.y) * sigmoidf_(v0[3]));
                    w.z = pk2(bflo(gin.z) * sigmoidf_(v1[0]), bfhi(gin.z) * sigmoidf_(v1[1])); w.w = pk2(bflo(gin.w) * sigmoidf_(v1[2]), bfhi(gin.w) * sigmoidf_(v1[3]));
                    *(v4u*)(YA + ro + bj * 128) = w;
                }
                asm volatile("" ::: "memory");
            }
    }
};
struct EpiBranch {
    static constexpr bool PERM = true, AFTER_DRAIN = false;
    const bf16* P; bf16* MM;
    __device__ __forceinline__ void operator()(const f32x4 (&acc)[2][2][4][2], const Unit& u, int wr, int wc, int fr, int fq) const {
        const int b = u.pn >> 2, pn = u.pn & 3, pm = u.pm - 66 * b;
        const int row0 = pm * 256 + wr * 64 + fr, col0 = pn * 256 + wc * 32 + 8 * fq;
#pragma unroll
        for (int ai = 0; ai < 2; ++ai)
#pragma unroll
            for (int m = 0; m < 4; ++m) {
                const int row = row0 + ai * 128 + m * 16;
                const bf16* gp = P + (size_t)row * PJ + 512 + b * 1024 + col0;
                bf16* mp = MM + (size_t)row * D + col0;
#pragma unroll
                for (int bj = 0; bj < 2; ++bj) {
                    const v4u gin = *(const v4u*)(gp + bj * 128);
                    const f32x4 v0 = acc[ai][bj][m][0], v1 = acc[ai][bj][m][1];
                    float o[8] = {bflo(gin.x) * v0[0], bfhi(gin.x) * v0[1], bflo(gin.y) * v0[2], bfhi(gin.y) * v0[3], bflo(gin.z) * v1[0], bfhi(gin.z) * v1[1], bflo(gin.w) * v1[2], bfhi(gin.w) * v1[3]};
                    if (b != 0) {
                        const unsigned long long* mq = (const unsigned long long*)(mp + bj * 128);
                        const unsigned long long q0 = __hip_atomic_load(mq, __ATOMIC_RELAXED, __HIP_MEMORY_SCOPE_AGENT), q1 = __hip_atomic_load(mq + 1, __ATOMIC_RELAXED, __HIP_MEMORY_SCOPE_AGENT);
                        v4u pv; pv.x = (unsigned)q0; pv.y = (unsigned)(q0 >> 32); pv.z = (unsigned)q1; pv.w = (unsigned)(q1 >> 32);
                        o[0] += bflo(pv.x); o[1] += bfhi(pv.x); o[2] += bflo(pv.y); o[3] += bfhi(pv.y); o[4] += bflo(pv.z); o[5] += bfhi(pv.z); o[6] += bflo(pv.w); o[7] += bfhi(pv.w); }
                    v4u w; w.x = pk2(o[0], o[1]); w.y = pk2(o[2], o[3]); w.z = pk2(o[4], o[5]); w.w = pk2(o[6], o[7]);
                    *(v4u*)(mp + bj * 128) = w;
                }
                asm volatile("" ::: "memory");
            }
    }
};
struct BranchOrder {
    int G, c, ntile;
    __device__ bool next(int i, Unit& u) const {
        const int T = (i / 3) * G + c, b = i % 3; if (T >= ntile) return false;
        const int pm = T >> 2, pn = T & 3; u.pm = 66 * b + pm; u.pn = 4 * b + pn; u.kofs = 0; return true;
    }
    __device__ __forceinline__ void a_ready(const Unit&) const {}
    __device__ __forceinline__ void done(const Unit&) const {}
};

struct CtxChunkOrder {
    int G, c, nchunk;
    __device__ bool next(int i, Unit& u) const {
        const int L = i * G + c; if (L >= 8 * nchunk) return false;
        const int tile = L & 7, ch = L >> 3; u.pm = 64 + (tile >> 2); u.pn = tile & 3; u.kofs = ch * 256; return true;
    }
    __device__ __forceinline__ void a_ready(const Unit&) const {}
    __device__ __forceinline__ void done(const Unit&) const {}
};
struct EpiResSlab {
    static constexpr bool PERM = false, AFTER_DRAIN = false;
    float* slab; const float* gate  ; float coef;
    __device__ __forceinline__ void operator()(const f32x4 (&acc)[2][2][4][2], const Unit& u, int wr, int wc, int fr, int fq) const {
        const int col0 = u.pn * 256 + wc * 32 + 4 * fq;
        float* pbase = slab + ((size_t)(u.kofs >> 8) * RC + (size_t)(u.pm - 64) * 256 + wr * 64 + fr) * D + col0;
#pragma unroll
        for (int ai = 0; ai < 2; ++ai)
#pragma unroll
            for (int m = 0; m < 4; ++m) {
                float* p = pbase + (ai * 128 + m * 16) * D;
#pragma unroll
                for (int bj = 0; bj < 2; ++bj)
#pragma unroll
                    for (int n = 0; n < 2; ++n) *(f32x4*)(p + bj * 128 + n * 16) = *(const f32x4*)(gate + col0 + bj * 128 + n * 16) * coef * acc[ai][bj][m][n];
                asm volatile("" ::: "memory");
            }
    }
};

__device__ __forceinline__ void transpose_item(const float* Wsrc  , int N, bf16* dst, int ldk, LAS float* scr, int lane) {
#pragma unroll 8
    for (int i = 0; i < 32; ++i) { const int kk = 2 * i + (lane >> 5); scr[kk * 33 + (lane & 31)] = Wsrc[(size_t)kk * N + (lane & 31)]; }
    asm volatile("s_waitcnt lgkmcnt(0)" ::: "memory");
    const int c = lane & 7;
#pragma unroll
    for (int j = 0; j < 4; ++j) { const int n = (lane >> 3) + 8 * j; const LAS float* s = scr + (8 * c) * 33 + n;
        v4u o; o.x = pk2(s[0 * 33], s[1 * 33]); o.y = pk2(s[2 * 33], s[3 * 33]); o.z = pk2(s[4 * 33], s[5 * 33]); o.w = pk2(s[6 * 33], s[7 * 33]);
        *(v4u*)(dst + (size_t)n * ldk + 8 * c) = o; }
    asm volatile("s_waitcnt lgkmcnt(0)" ::: "memory");
}

struct Args {
    const float* in[25]; float* out; unsigned char* ws;
};
struct Ctx {
    unsigned char* ws;
    __device__ __forceinline__ const float* in(int i) const { return ((const float* const*)(ws + WS_PTRS))[i]; }
    __device__ __forceinline__ float* out() const { return ((float* const*)(ws + WS_PTRS))[25]; }
};

constexpr int IT_UP = 16 * 88, IT_DN = 44 * 32, IT_IN = 16 * 208, IT_GLU = 8 * 16, IT_BR = 8 * 32, IT_OUT = 16 * 32;
constexpr int IT_LAYER = 4 * IT_UP + 2 * IT_DN + IT_IN + IT_GLU + 3 * IT_BR + IT_OUT;

__device__ __forceinline__ void convert_item(const Args& a, int it, LAS float* scr, int lane) {
    const int l = it / IT_LAYER; int r = it % IT_LAYER;
    unsigned char* wl = a.ws + WS_W + (size_t)l * WL_BYTES;
    if (r < 4 * IT_UP) {
        const int which = r / IT_UP, s = which >> 1, isu = which & 1; r %= IT_UP;
        const int kb = r / 88, nb = r % 88, k0 = 64 * kb, n0 = 32 * nb;
        const float* src = a.in[isu ? 9 : 8] + ((size_t)(l * 2 + s) * D + k0) * FF + n0;
        bf16* dst = (bf16*)(wl + (s ? WO_UP1 : WO_UP0)) + (size_t)(256 * (n0 >> 7) + (n0 & 127) + 128 * isu) * D + k0;
        transpose_item(src, FF, dst, D, scr, lane); return;
    }
    r -= 4 * IT_UP;
    if (r < 2 * IT_DN) {
        const int s = r / IT_DN; r %= IT_DN;
        const int kb = r / 32, nb = r % 32, k0 = 64 * kb, n0 = 32 * nb;
        const float* src = a.in[10] + ((size_t)(l * 2 + s) * FF + k0) * D + n0;
        bf16* dst = (bf16*)(wl + (s ? WO_DN1 : WO_DN0)) + (size_t)n0 * FF + k0;
        transpose_item(src, D, dst, FF, scr, lane); return;
    }
    r -= 2 * IT_DN;
    if (r < IT_IN) {
        const int kb = r / 208, nb = r % 208, k0 = 64 * kb, n0 = 32 * nb;
        const float* src = a.in[11] + ((size_t)l * D + k0) * DIN + n0;
        bf16* dst = (bf16*)(wl + WO_IN) + (size_t)n0 * D + k0;
        transpose_item(src, DIN, dst, D, scr, lane); return;
    }
    r -= IT_IN;
    if (r < IT_GLU) {
        const int kb = r / 16, nb = r % 16, k0 = 64 * kb, n0 = 32 * nb;
        const float* src = a.in[20] + ((size_t)l * 512 + k0) * 512 + n0;
        bf16* dst = (bf16*)(wl + WO_G) + (size_t)n0 * 512 + k0;
        transpose_item(src, 512, dst, 512, scr, lane); return;
    }
    r -= IT_GLU;
    if (r < 3 * IT_BR) {
        const int b = r / IT_BR; r %= IT_BR;
        const int kb = r / 32, nb = r % 32, k0 = 64 * kb, n0 = 32 * nb;
        const float* src = a.in[23] + ((size_t)(l * 3 + b) * 512 + k0) * D + n0;
        bf16* dst = (bf16*)(wl + WO_G) + (size_t)(512 + b * 1024 + n0) * 512 + k0;
        transpose_item(src, D, dst, 512, scr, lane); return;
    }
    r -= 3 * IT_BR;
    {
        const int kb = r / 32, nb = r % 32, k0 = 64 * kb, n0 = 32 * nb;
        const float* src = a.in[24] + ((size_t)l * D + k0) * D + n0;
        bf16* dst = (bf16*)(wl + WO_OUT) + (size_t)n0 * D + k0;
        transpose_item(src, D, dst, D, scr, lane);
    }
}

__device__ __forceinline__ void s5_tables(const Args& a, int idx) {
    const int p = idx & 63, g = (idx >> 6) & 31, dir = (idx >> 11) & 1, l = idx >> 12;
    const int ldg = (l * 2 + dir) * 32 + g;
    const double lr = (double)a.in[12][ldg * 64 + p], li = (double)a.in[13][ldg * 64 + p];
    const double dt = exp((double)a.in[14][ldg]);
    const double mag = exp(lr * dt); double sn, cs; sincos(li * dt, &sn, &cs);
    const double ar = mag * cs, ai = mag * sn;
    float* lam = (float*)(a.ws + WS_LAM); float* lamL = (float*)(a.ws + WS_LAML);
    lam[(ldg * 64 + p) * 2] = (float)ar; lam[(ldg * 64 + p) * 2 + 1] = (float)ai;
    double pr = ar, pi = ai;
#pragma unroll
    for (int i = 0; i < 7; ++i) { const double nr = pr * pr - pi * pi, ni = 2.0 * pr * pi; pr = nr; pi = ni; }
    lamL[(ldg * 64 + p) * 2] = (float)pr; lamL[(ldg * 64 + p) * 2 + 1] = (float)pi;
    const double den = lr * lr + li * li, nr = ar - 1.0, ni = ai;
    const double cr = (nr * lr + ni * li) / den, ci = (ni * lr - nr * li) / den;
    bf16* BB = (bf16*)(a.ws + WS_BB);
    const float* bre = a.in[15] + ((size_t)ldg * 64 + p) * 16; const float* bim = a.in[16] + ((size_t)ldg * 64 + p) * 16;
#pragma unroll
    for (int i = 0; i < 16; ++i) {
        const double br = bre[i], bi = bim[i];
        BB[(((size_t)ldg * 2 + 0) * 64 + p) * 16 + i] = (bf16)f2bf((float)(cr * br - ci * bi));
        BB[(((size_t)ldg * 2 + 1) * 64 + p) * 16 + i] = (bf16)f2bf((float)(cr * bi + ci * br));
    }
    bf16* CT = (bf16*)(a.ws + WS_CT);
    const float* cre = a.in[17] + (size_t)ldg * 16 * 64; const float* cim = a.in[18] + (size_t)ldg * 16 * 64;
#pragma unroll
    for (int h = 0; h < 16; ++h) {
        CT[((size_t)ldg * 16 + h) * 128 + 2 * p] = (bf16)f2bf(cre[h * 64 + p]);
        CT[((size_t)ldg * 16 + h) * 128 + 2 * p + 1] = (bf16)f2bf(-cim[h * 64 + p]);
    }
}

__device__ __forceinline__ void mod_row(const float* xrow, const float* shift, const float* scale, bf16* hrow, int lane) {
    const f32x4* xr = (const f32x4*)xrow + lane; const f32x4* sh = (const f32x4*)shift + lane; const f32x4* sc = (const f32x4*)scale + lane;
    unsigned long long* o8 = (unsigned long long*)hrow + lane;
#pragma unroll
    for (int j = 0; j < 4; ++j) { const f32x4 v = xr[64 * j] * (sc[64 * j] + 1.0f) + sh[64 * j];
        o8[64 * j] = (unsigned long long)pk2(v[0], v[1]) | ((unsigned long long)pk2(v[2], v[3]) << 32); }
}
__device__ __forceinline__ void ln_row(float* xrow, const float* g, const float* b, const float* shift, const float* scale, bf16* hrow, int lane, float oscale, const float* slab_row, int nslab) {
    f32x4* xr = (f32x4*)xrow + lane;
    f32x4 v[4]; float s = 0.f;
#pragma unroll
    for (int j = 0; j < 4; ++j) v[j] = xr[64 * j];
    for (int k = 0; k < nslab; ++k) { const f32x4* sp = (const f32x4*)(slab_row + (size_t)k * RC * D) + lane;
#pragma unroll
        for (int j = 0; j < 4; ++j) v[j] += sp[64 * j]; }
#pragma unroll
    for (int j = 0; j < 4; ++j) s += (v[j][0] + v[j][1]) + (v[j][2] + v[j][3]);
    const float mean = wave_sum(s) * (1.f / D); float s2 = 0.f;
#pragma unroll
    for (int j = 0; j < 4; ++j) { v[j] = v[j] - mean; s2 += (v[j][0] * v[j][0] + v[j][1] * v[j][1]) + (v[j][2] * v[j][2] + v[j][3] * v[j][3]); }
    const float rstd = 1.f / sqrtf(wave_sum(s2) * (1.f / D) + LN_EPS);
    const f32x4* gg = (const f32x4*)g + lane; const f32x4* bb = (const f32x4*)b + lane;
#pragma unroll
    for (int j = 0; j < 4; ++j) { v[j] = v[j] * rstd * gg[64 * j] + bb[64 * j]; xr[64 * j] = v[j] * oscale; }
    if (hrow) {
        const f32x4* sh = (const f32x4*)shift + lane; const f32x4* sc = (const f32x4*)scale + lane;
        unsigned long long* o8 = (unsigned long long*)hrow + lane;
#pragma unroll
        for (int j = 0; j < 4; ++j) { const f32x4 w = v[j] * (sc[64 * j] + 1.0f) + sh[64 * j];
            o8[64 * j] = (unsigned long long)pk2(w[0], w[1]) | ((unsigned long long)pk2(w[2], w[3]) << 32); }
    }
}

#define MFMA32(a, b, c) __builtin_amdgcn_mfma_f32_32x32x16_bf16((a), (b), (c), 0, 0, 0)
#define MFMA16(a, b, c) __builtin_amdgcn_mfma_f32_16x16x32_bf16((a), (b), (c), 0, 0, 0)
constexpr int S5_ROWB = 272, S5_BATB = 16 * S5_ROWB, S5_WAVEB = 2 * S5_BATB;

template <bool PASS2>
__device__ __forceinline__ void s5_task(const Ctx& a, int l, int g, int ch, LAS unsigned char* wl, int lane) {
    const int j = lane & 31, hl = lane >> 5;
    const bf16* P = (const bf16*)(a.ws + WS_A);
    const float* LAM = (const float*)(a.ws + WS_LAM); const float* LAML = (const float*)(a.ws + WS_LAML);
    const bf16* BB = (const bf16*)(a.ws + WS_BB); const bf16* CT = (const bf16*)(a.ws + WS_CT);
    float* E = (float*)(a.ws + WS_E);
    const int rb0 = ch < 2 ? RL + 128 * ch : 128 * (ch - 2), rbstep = ch < 2 ? CTXL : SEQ;
    const int arow = rb0 + ((j >> 2) & 1) * rbstep + 4 * (j >> 3) + (j & 3);
    const bf16* ap = P + (size_t)arow * PJ + COL_U + g * 16 + 8 * hl;
    f32x4 yacc[8][2];
    if (PASS2) {
#pragma unroll
        for (int sb = 0; sb < 8; ++sb) { yacc[sb][0] = (f32x4){0.f, 0.f, 0.f, 0.f}; yacc[sb][1] = (f32x4){0.f, 0.f, 0.f, 0.f}; }
    }
    const f32x16 zero16 = {0.f, 0.f, 0.f, 0.f, 0.f, 0.f, 0.f, 0.f, 0.f, 0.f, 0.f, 0.f, 0.f, 0.f, 0.f, 0.f};
    bf16x8 ufa[8];
    if (PASS2) {
#pragma unroll
        for (int sb = 0; sb < 8; ++sb) ufa[sb] = *(const bf16x8*)(ap + (size_t)(16 * sb) * PJ);
    }
#pragma unroll
    for (int dir = 0; dir < 2; ++dir) {
        const int ldg = (l * 2 + dir) * 32 + g;
        float lr[2], li[2], sr[2], si[2];
#pragma unroll
        for (int ph = 0; ph < 2; ++ph) { lr[ph] = LAM[(ldg * 64 + j + 32 * ph) * 2]; li[ph] = LAM[(ldg * 64 + j + 32 * ph) * 2 + 1]; sr[ph] = 0.f; si[ph] = 0.f; }
        if (PASS2) {
            float Lr[2], Li[2];
#pragma unroll
            for (int ph = 0; ph < 2; ++ph) { Lr[ph] = LAML[(ldg * 64 + j + 32 * ph) * 2]; Li[ph] = LAML[(ldg * 64 + j + 32 * ph) * 2 + 1]; }
            const float* Eb = E + ((size_t)((dir * 32 + g) * NCH) * 2 + hl) * 128 + 2 * j;
            const int cnt = dir == 0 ? ch : (ch == 1 ? 0 : (ch == 0 ? 1 : 2 + (NCH - 1 - ch)));
            typedef float f32x2_t __attribute__((ext_vector_type(2)));
#pragma unroll 1
            for (int k0 = 0; k0 < cnt; k0 += 8) {
                f32x2_t ev[8][2];
#pragma unroll
                for (int q = 0; q < 8; ++q) { const int k = min(k0 + q, cnt - 1); const int cp = dir == 0 ? k : (k == 0 ? 1 : (k == 1 ? 0 : NCH + 1 - k));
                    ev[q][0] = *(const f32x2_t*)(Eb + (size_t)cp * 256); ev[q][1] = *(const f32x2_t*)(Eb + (size_t)cp * 256 + 64); }
#pragma unroll
                for (int q = 0; q < 8; ++q) if (k0 + q < cnt) {
#pragma unroll
                    for (int ph = 0; ph < 2; ++ph) { const float nr = Lr[ph] * sr[ph] - Li[ph] * si[ph] + ev[q][ph][0], ni = Lr[ph] * si[ph] + Li[ph] * sr[ph] + ev[q][ph][1]; sr[ph] = nr; si[ph] = ni; }
                }
            }
        }
        bf16x8 bfr[2][2];
#pragma unroll
        for (int ph = 0; ph < 2; ++ph)
#pragma unroll
            for (int ri = 0; ri < 2; ++ri) bfr[ph][ri] = *(const bf16x8*)(BB + (((size_t)ldg * 2 + ri) * 64 + j + 32 * ph) * 16 + 8 * hl);
        bf16x8 cfr[4];
        if (PASS2) {
#pragma unroll
            for (int ks = 0; ks < 4; ++ks) cfr[ks] = *(const bf16x8*)(CT + ((size_t)ldg * 16 + (lane & 15)) * 128 + 32 * ks + 8 * (lane >> 4));
        }
#pragma unroll
        for (int q = 0; q < (PASS2 ? 8 : 1); ++q)
#pragma unroll 1
        for (int q1 = 0; q1 < (PASS2 ? 1 : 8); ++q1) {
            const int sb = dir ? 7 - (q + q1) : (q + q1);
            bf16x8 uf;
            if (PASS2) uf = ufa[q]; else { const bf16* apq = ap; asm volatile("" : "+v"(apq)); uf = *(const bf16x8*)(apq + (size_t)(16 * sb) * PJ); }
            if (PASS2 && dir) uf = ufa[7 - q];
            f32x16 bu[2][2];
#pragma unroll
            for (int ph = 0; ph < 2; ++ph)
#pragma unroll
                for (int ri = 0; ri < 2; ++ri) bu[ph][ri] = MFMA32(uf, bfr[ph][ri], zero16);
#pragma unroll
            for (int rq = 0; rq < 16; ++rq) {
                const int r = dir ? 15 - rq : rq;
#pragma unroll
                for (int ph = 0; ph < 2; ++ph) {
                    const float nr = lr[ph] * sr[ph] - li[ph] * si[ph] + bu[ph][0][r], ni = lr[ph] * si[ph] + li[ph] * sr[ph] + bu[ph][1][r];
                    sr[ph] = nr; si[ph] = ni;
                    if (PASS2) *(LAS unsigned*)(wl + hl * S5_BATB + r * S5_ROWB + (j + 32 * ph) * 4) = pk2(nr, ni);
                }
            }
            if (PASS2) {
                asm volatile("s_waitcnt lgkmcnt(0)" ::: "memory");
#pragma unroll
                for (int bb = 0; bb < 2; ++bb)
#pragma unroll
                    for (int ks = 0; ks < 4; ++ks) {
                        const bf16x8 af = *(const LAS bf16x8*)(wl + bb * S5_BATB + (lane & 15) * S5_ROWB + (32 * ks + 8 * (lane >> 4)) * 2);
                        yacc[sb][bb] = MFMA16(af, cfr[ks], yacc[sb][bb]);
                    }
                asm volatile("s_waitcnt lgkmcnt(0)" ::: "memory");
            }
        }
        if (!PASS2) {
            float* e_ = E + ((size_t)((dir * 32 + g) * NCH + ch) * 2 + hl) * 128 + 2 * j;
#pragma unroll
            for (int ph = 0; ph < 2; ++ph) { e_[64 * ph] = sr[ph]; e_[64 * ph + 1] = si[ph]; }
        }
    }
    if (PASS2) {
        const int h = lane & 15, fq = lane >> 4;
        const float dv = a.in(19)[l * 512 + g * 16 + h];
        bf16* GA = (bf16*)(a.ws + WS_VT);
#pragma unroll
        for (int sb = 0; sb < 8; ++sb)
#pragma unroll
            for (int bb = 0; bb < 2; ++bb)
#pragma unroll
                for (int e = 0; e < 4; ++e) {
                    const int row = rb0 + bb * rbstep + 16 * sb + 4 * fq + e;
                    const float uu = bf2f(P[(size_t)row * PJ + COL_U + g * 16 + h]);
                    GA[(size_t)row * 512 + g * 16 + h] = (bf16)f2bf(gelu_tanh(yacc[sb][bb][e] + dv * uu));
                }
    }
}

constexpr float LOG2E = 1.4426950408889634f;
__device__ __forceinline__ void attn_task(const Ctx& a, int kind, int b, int h, int r, int jq, const LAS float* rpb  , int lane) {
    const int j = lane & 31, hl = lane >> 5;
    const bf16* P = (const bf16*)(a.ws + WS_A);
    const bf16* VT = (const bf16*)(a.ws + WS_VT) + (size_t)(b * 8 + h) * 64 * TOKP;
    bf16* YB = (bf16*)(a.ws + WS_Y3) + (size_t)R * 512;
    const int c = 32 * jq + j;
    const int rowq = kind == 0 ? b * SEQ + r * 64 + c : RL + b * CTXL + 32 * jq + j;
    bf16x8 qf[4];
#pragma unroll
    for (int s = 0; s < 4; ++s) qf[s] = *(const bf16x8*)(P + (size_t)rowq * PJ + COL_Q + h * 64 + 16 * s + 8 * hl);
    const int ka = j >> 3, kk = 16 * (ka >> 1) + 8 * ((j >> 2) & 1) + 4 * (ka & 1) + (j & 3);
    const f32x16 zero16 = {0.f, 0.f, 0.f, 0.f, 0.f, 0.f, 0.f, 0.f, 0.f, 0.f, 0.f, 0.f, 0.f, 0.f, 0.f, 0.f};
    f32x16 o0 = zero16, o1 = zero16;
    float m = -1e30f, lsum = 0.f;
    const int rs = min(max(r - 4, 0), 120), cs = min(max(c - 8, 0), 48);
    const float SC = 0.125f * LOG2E;
    const int ntile = kind == 0 ? 20 : 8;
    for (int t = 0; t < ntile; ++t) {
        int krow, tok0, tok1;
        int kr0 = 0, kc0 = 0;
        const bool win = t >= 8;
        if (!win) { krow = RL + b * CTXL + 32 * t + kk; tok0 = SEQ + 32 * t + 8 * hl; tok1 = tok0 + 16; }
        else { const int w = t - 8, jr2 = w / 3, cb = jq + (w - 3 * jr2); kr0 = rs + 2 * jr2; kc0 = 16 * cb;
            krow = b * SEQ + (kr0 + (kk >> 4)) * 64 + kc0 + (kk & 15); tok0 = kr0 * 64 + kc0 + 8 * hl; tok1 = tok0 + 64; }
        const bf16* kp = P + (size_t)krow * PJ + COL_K + h * 64 + 8 * hl;
        bf16x8 kf[4];
#pragma unroll
        for (int s = 0; s < 4; ++s) kf[s] = *(const bf16x8*)(kp + 16 * s);
        bf16x8 vf[2][2];
#pragma unroll
        for (int dh = 0; dh < 2; ++dh) { vf[0][dh] = *(const bf16x8*)(VT + (size_t)(32 * dh + j) * TOKP + tok0); vf[1][dh] = *(const bf16x8*)(VT + (size_t)(32 * dh + j) * TOKP + tok1); }
        f32x16 p = zero16;
#pragma unroll
        for (int s = 0; s < 4; ++s) p = MFMA32(kf[s], qf[s], p);
        float mx = -1e30f;
        if (!win) {
#pragma unroll
            for (int rr = 0; rr < 16; ++rr) { p[rr] *= SC; mx = fmaxf(mx, p[rr]); }
        } else {
            const LAS float* rp = rpb + h * 465;
#pragma unroll
            for (int rr = 0; rr < 16; ++rr) {
                const int kc = kc0 + 8 * hl + (rr & 7), kr = kr0 + (rr >> 3);
                const bool valid = (kc >= cs) && (kc < cs + 16);
                const int dc = min(max(kc - c + 15, 0), 30);
                const float bias = rp[(kr - r + 7) * 31 + dc];
                const float sv = valid ? p[rr] * SC + bias : -1e30f;
                p[rr] = sv; mx = fmaxf(mx, sv);
            }
        }
        mx = fmaxf(mx, __shfl_xor(mx, 32));
        const float mnew = fmaxf(m, mx), al = __builtin_amdgcn_exp2f(m - mnew);
        m = mnew;
        float ps = 0.f;
#pragma unroll
        for (int rr = 0; rr < 16; ++rr) { p[rr] = __builtin_amdgcn_exp2f(p[rr] - mnew); ps += p[rr]; }
        lsum = lsum * al + ps;
#pragma unroll
        for (int rr = 0; rr < 16; ++rr) { o0[rr] *= al; o1[rr] *= al; }
        bf16x8 pf[2];
#pragma unroll
        for (int sl = 0; sl < 2; ++sl) { v4u w; w.x = pk2(p[8 * sl], p[8 * sl + 1]); w.y = pk2(p[8 * sl + 2], p[8 * sl + 3]); w.z = pk2(p[8 * sl + 4], p[8 * sl + 5]); w.w = pk2(p[8 * sl + 6], p[8 * sl + 7]);
            pf[sl] = __builtin_bit_cast(bf16x8, w); }
#pragma unroll
        for (int sl = 0; sl < 2; ++sl) { o0 = MFMA32(vf[sl][0], pf[sl], o0); o1 = MFMA32(vf[sl][1], pf[sl], o1); }
    }
    const float ltot = lsum + __shfl_xor(lsum, 32), inv = 1.0f / ltot;
    bf16* yp = YB + (size_t)rowq * 512 + h * 64 + 4 * hl;
#pragma unroll
    for (int gq = 0; gq < 4; ++gq) {
        v2u w0, w1;
        w0.x = pk2(o0[4 * gq] * inv, o0[4 * gq + 1] * inv); w0.y = pk2(o0[4 * gq + 2] * inv, o0[4 * gq + 3] * inv);
        w1.x = pk2(o1[4 * gq] * inv, o1[4 * gq + 1] * inv); w1.y = pk2(o1[4 * gq + 2] * inv, o1[4 * gq + 3] * inv);
        *(v2u*)(yp + 8 * gq) = w0; *(v2u*)(yp + 32 + 8 * gq) = w1;
    }
}

__device__ __forceinline__ void conv_item(const Ctx& a, int l, int item) {
    const int row = item >> 6, ch = (item & 63) * 8;
    const bf16* P = (const bf16*)(a.ws + WS_A);
    bf16* YC = (bf16*)(a.ws + WS_Y3) + (size_t)2 * R * 512;
    int t, T; if (row < RL) { t = row & 8191; T = SEQ; } else { t = (row - RL) & 255; T = CTXL; }
    const float* cw = a.in(22) + (size_t)l * 3 * 512 + ch;
    float y[8] = {0.f, 0.f, 0.f, 0.f, 0.f, 0.f, 0.f, 0.f};
#pragma unroll
    for (int i = 0; i < 3; ++i) {
        const int tt = t + i - 1; if (tt < 0 || tt >= T) continue;
        const bf16* rp = P + (size_t)(row + i - 1) * PJ + ch;
        const v4u z = *(const v4u*)(rp + COL_Z), cg_ = *(const v4u*)(rp + COL_C);
        const f32x4 w0 = *(const f32x4*)(cw + i * 512), w1 = *(const f32x4*)(cw + i * 512 + 4);
        y[0] += w0[0] * bflo(z.x) * bflo(cg_.x); y[1] += w0[1] * bfhi(z.x) * bfhi(cg_.x); y[2] += w0[2] * bflo(z.y) * bflo(cg_.y); y[3] += w0[3] * bfhi(z.y) * bfhi(cg_.y);
        y[4] += w1[0] * bflo(z.z) * bflo(cg_.z); y[5] += w1[1] * bfhi(z.z) * bfhi(cg_.z); y[6] += w1[2] * bflo(z.w) * bflo(cg_.w); y[7] += w1[3] * bfhi(z.w) * bfhi(cg_.w);
    }
    const v4u bg = *(const v4u*)(P + (size_t)row * PJ + COL_B + ch);
    v4u w; w.x = pk2(y[0] * bflo(bg.x), y[1] * bfhi(bg.x)); w.y = pk2(y[2] * bflo(bg.y), y[3] * bfhi(bg.y)); w.z = pk2(y[4] * bflo(bg.z), y[5] * bfhi(bg.z)); w.w = pk2(y[6] * bflo(bg.w), y[7] * bfhi(bg.w));
    *(v4u*)(YC + (size_t)row * 512 + ch) = w;
}

typedef GAS unsigned gu32;
#define XB_TMO      128
#define XB_XCNT(j)  (256  + 64 * (j))
#define XB_XSUB(j)  (1280 + 64 * (j))
#define XB_XGEN(j)  (2304 + 64 * (j))
#define XB_TOP      3328
#define XB_TOPGEN   3392
#define XCD_BAR_WORDS 3456
#define XB_SPIN_CAP (1u << 18)

__device__ __forceinline__ unsigned xb_ld(unsigned* p)              { return __hip_atomic_load(p, __ATOMIC_RELAXED, __HIP_MEMORY_SCOPE_AGENT); }
__device__ __forceinline__ unsigned xb_add(unsigned* p, unsigned v) { return __hip_atomic_fetch_add(p, v, __ATOMIC_RELAXED, __HIP_MEMORY_SCOPE_AGENT); }
__device__ __forceinline__ unsigned xb_xcc_id() { return (unsigned)__builtin_amdgcn_s_getreg((3 << 11) | 20) & 0xFu; }
#define XB_SPIN(cond, bar) do { unsigned _sp = 0; while (cond) { __builtin_amdgcn_s_sleep(1); \
    if ((++_sp & 255u) == 0u) { if (xb_ld(&(bar)[XB_TMO])) break; if (_sp > XB_SPIN_CAP) { atomicAdd(&(bar)[XB_TMO], 1u); break; } } } } while (0)

struct XcdBarrier {
    unsigned* bar; unsigned x;
    volatile LAS unsigned* st;
};

__device__ __forceinline__ XcdBarrier xcd_barrier_post(unsigned* bar, volatile LAS unsigned* st) {
    XcdBarrier b; b.bar = bar; b.x = xb_xcc_id(); b.st = st;
    if (threadIdx.x == 0) (void)xb_add(&bar[XB_XCNT(b.x)], 1u);
    return b;
}
__device__ __forceinline__ void xcd_barrier_complete(unsigned* bar, unsigned x, unsigned& nloc, unsigned& nx) {
    const unsigned G = gridDim.x * gridDim.y * gridDim.z;
    unsigned sum, cnt, mine, sp = 0u;
    for (;;) {
        sum = 0u; cnt = 0u; mine = 0u;
#pragma unroll
        for (unsigned j = 0; j < 16; ++j) { const unsigned c = xb_ld(&bar[XB_XCNT(j)]); sum += c; cnt += (c > 0u) ? 1u : 0u; mine = (j == x) ? c : mine; }
        if (sum == G) break;
        __builtin_amdgcn_s_sleep(1);
        if ((++sp & 255u) == 0u) { if (xb_ld(&bar[XB_TMO])) break; if (sp > XB_SPIN_CAP) { atomicAdd(&bar[XB_TMO], 1u); break; } }
    }
    nloc = mine > 0u ? mine : 1u; nx = cnt > 0u ? cnt : 1u;
}

__device__ __forceinline__ void xcd_barrier(const XcdBarrier& b) {
    asm volatile("s_waitcnt vmcnt(0)" ::: "memory");
    __syncthreads();
    if (threadIdx.x == 0) {
        unsigned* bar = b.bar;
        __builtin_amdgcn_s_waitcnt(0);
        unsigned nloc = b.st[0], nx = b.st[1];
        if (nloc == 0u) { xcd_barrier_complete(bar, b.x, nloc, nx); b.st[0] = nloc; b.st[1] = nx; }
        const unsigned old = xb_add(&bar[XB_XSUB(b.x)], 1u);
        const unsigned gen = old / nloc;
        if (old + 1u == (gen + 1u) * nloc) {
            __builtin_amdgcn_fence(__ATOMIC_RELEASE, "agent");
            asm volatile("s_waitcnt vmcnt(0)" ::: "memory");
            const unsigned og = xb_add(&bar[XB_TOP], 1u);
            const unsigned tg = og / nx;
            if (og + 1u == (tg + 1u) * nx) xb_add(&bar[XB_TOPGEN], 1u);
            else XB_SPIN(xb_ld(&bar[XB_TOPGEN]) == tg, bar);
            __builtin_amdgcn_fence(__ATOMIC_ACQUIRE, "agent");
            xb_add(&bar[XB_XGEN(b.x)], 1u);
            asm volatile("s_waitcnt vmcnt(0)" ::: "memory");
        } else {
            XB_SPIN(xb_ld(&bar[XB_XGEN(b.x)]) == gen, bar);
            __builtin_amdgcn_fence(__ATOMIC_ACQUIRE, "agent");
            asm volatile("s_waitcnt vmcnt(0)" ::: "memory");
        }
    }
    __syncthreads();
}

template <class Epi, class Sched>
__device__ __forceinline__ void run_gemm(LAS unsigned char* lds, const bf16* A, const bf16* Bt, int M, int N, int K, const Sched& S, const Epi& E) {
    pg8::Gemm g{A, Bt, M, N, K, K};
    pg8::gemm_phase<Epi, Sched, true, true>(lds, g, S, E);
}
template <class Epi, class Sched>
__device__ __forceinline__ void run_gemm_chunk(LAS unsigned char* lds, const bf16* A, const bf16* Bt, int M, int N, int Kc, int ld, const Sched& S, const Epi& E) {
    pg8::Gemm g{A, Bt, M, N, Kc, ld};
    pg8::gemm_phase<Epi, Sched, true, true>(lds, g, S, E);
}

__global__ void __launch_bounds__(NWAVES * 64, 2) fwd_megakernel(Args a) {
    extern __shared__ __attribute__((aligned(16))) unsigned char lds_raw[];
    LAS unsigned char* lds = (LAS unsigned char*)lds_raw;
    LAS float* misc = (LAS float*)(lds + 131072);
    cg::grid_group grid = cg::this_grid();
    int tid = threadIdx.x, lane = tid & 63; int wave = __builtin_amdgcn_readfirstlane(tid >> 6);
    int G = gridDim.x, bx = blockIdx.x;
    int gw = bx * NWAVES + wave, NGW = G * NWAVES, NGT = G * NWAVES * 64; int gt = bx * (NWAVES * 64) + tid;
    Ctx c; c.ws = a.ws;
    volatile LAS unsigned* xst = (volatile LAS unsigned*)(lds + 131072 + 16128);
    if (tid < 2) xst[tid] = 0u;
    __syncthreads();
    (void)xcd_barrier_post((unsigned*)(a.ws + WS_BAR), xst);
#define PHASE_OPAQUE() do { tid = threadIdx.x; asm volatile("" : "+v"(tid)); lane = tid & 63; { int b_ = blockIdx.x, g_ = gridDim.x; asm volatile("" : "+v"(b_), "+v"(g_)); bx = __builtin_amdgcn_readfirstlane(b_); G = __builtin_amdgcn_readfirstlane(g_); } \
        NGW = G * NWAVES; NGT = G * NWAVES * 64; gt = bx * (NWAVES * 64) + tid; wave = __builtin_amdgcn_readfirstlane(tid >> 6); gw = bx * NWAVES + wave; \
        unsigned lo_ = (unsigned)(uintptr_t)a.ws, hi_ = (unsigned)((uintptr_t)a.ws >> 32); asm volatile("" : "+v"(lo_), "+v"(hi_)); \
        lo_ = __builtin_amdgcn_readfirstlane(lo_); hi_ = __builtin_amdgcn_readfirstlane(hi_); c.ws = (unsigned char*)(((uintptr_t)hi_ << 32) | (uintptr_t)lo_); } while (0)
#define SYNC() do { XcdBarrier b_; b_.bar = (unsigned*)(c.ws + WS_BAR); b_.x = xb_xcc_id(); b_.st = (volatile LAS unsigned*)(lds + 131072 + 16128); xcd_barrier(b_); PHASE_OPAQUE(); } while (0)
#define SYNC_CG() do { asm volatile("s_waitcnt vmcnt(0)" ::: "memory"); __syncthreads(); \
        if (wave == 0) { __builtin_amdgcn_fence(__ATOMIC_RELEASE, "agent"); asm volatile("s_waitcnt vmcnt(0)" ::: "memory"); } \
        grid.sync(); \
        __builtin_amdgcn_fence(__ATOMIC_ACQUIRE, "agent"); asm volatile("s_waitcnt vmcnt(0)" ::: "memory"); __syncthreads(); \
        PHASE_OPAQUE(); } while (0)
#define WSP(T, off) ((T*)(c.ws + (off)))
#ifndef DBG_STOP
#define DBG_STOP -1
#endif
#define DBG(k, off, nelem) do { if (DBG_STOP == (k)) { if ((nelem) > 0) { const bf16* s_ = WSP(bf16, off); float* o_ = c.out(); \
        for (size_t i_ = (size_t)gt; i_ < (size_t)RL * D; i_ += (size_t)NGT) o_[i_] = bf2f(s_[i_ % (size_t)(nelem)]); } return; } } while (0)
#define XROW(row) ((row) < RL ? c.out() + (size_t)(row) * D : WSP(float, WS_XC) + (size_t)((row) - RL) * D)

    if (tid < 26) ((const float**)(a.ws + WS_PTRS))[tid] = tid < 25 ? a.in[tid] : (const float*)a.out;
    for (int i = tid; i < 3 * D; i += NWAVES * 64) { const int mid = i >> 10, k = i & 1023; const float cv = mid < 2 ? a.in[1][mid * D + k] : a.in[3][k]; misc[i] = cv / (1.0f + expf(-cv)); }
    __syncthreads();
    {
        float* modv = (float*)(a.ws + WS_MODV);
        for (int idx = gt; idx < 2 * 16 * NMODV; idx += NGT) {
            const int n = idx % NMODV, kc = (idx / NMODV) & 15, l = idx / (NMODV * 16);
            const float* w = a.in[4] + ((size_t)l * D + 64 * kc) * NMODV + n;
            float a0 = 0.f, a1 = 0.f, a2 = 0.f;
#pragma unroll 8
            for (int k = 0; k < 64; ++k) { const float wv = w[(size_t)k * NMODV]; a0 += misc[64 * kc + k] * wv; a1 += misc[D + 64 * kc + k] * wv; a2 += misc[2 * D + 64 * kc + k] * wv; }
            if (kc == 0) { const float bm = a.in[5][l * NMODV + n]; a0 += bm; a1 += bm; a2 += bm; }
            atomicAdd(modv + (size_t)(l * 3 + 0) * NMODV + n, a0); atomicAdd(modv + (size_t)(l * 3 + 1) * NMODV + n, a1); atomicAdd(modv + (size_t)(l * 3 + 2) * NMODV + n, a2);
        }
    }
    if (gt < 8192) s5_tables(a, gt);
    __syncthreads();
    {
        LAS float* scr = (LAS float*)(lds + wave * 16384);
        for (int it = gw; it < 2 * IT_LAYER; it += NGW) convert_item(a, it, scr, lane);
    }
    SYNC_CG();
    for (int row = gw; row < R; row += NGW) {
        const float* xrow = row < RL ? c.in(0) + (size_t)row * D : c.in(2) + (size_t)(row - RL) * D;
        const float* mv = WSP(float, WS_MODV) + (size_t)mid_of_row(row) * NMODV;
        mod_row(xrow, mv, mv + D, WSP(bf16, WS_H) + (size_t)row * D, lane);
        if (row >= RL) { const f32x4* xr = (const f32x4*)xrow + lane; f32x4* xo = (f32x4*)(WSP(float, WS_XC) + (size_t)(row - RL) * D) + lane;
#pragma unroll
            for (int j = 0; j < 4; ++j) xo[64 * j] = xr[64 * j] * ALPHA; }
    }
    SYNC();

    DBG(1, WS_H, (size_t)R * D);
    DBG(2, WS_W, (size_t)WL_BYTES / 2);
#pragma unroll 1
    for (int l = 0; l < 2; ++l) {
#define WL(off) ((const bf16*)(c.ws + WS_W + (size_t)l * WL_BYTES + (off)))
#define MVL (WSP(float, WS_MODV) + (size_t)l * 3 * NMODV)
        pg8::StaticOrder SO;
        const int RM = l == 0 ? R : RL;
        { SO.init(R, NUP, G, bx); EpiSwiglu E{WSP(bf16, WS_A)}; run_gemm(lds, WSP(bf16, WS_H), WL(WO_UP0), R, NUP, D, SO, E); }
        SYNC();
        DBG(10 + 100 * l, WS_A, (size_t)R * FF);
        { SO.init(RL, D, G, bx); float* XL = c.out(); float* XC = WSP(float, WS_XC);
          EpiRes E{l == 0 ? c.in(0) : XL, XC, XL, XC, MVL + 2 * D, 0.5f}; run_gemm(lds, WSP(bf16, WS_A), WL(WO_DN0), RL, D, FF, SO, E); }
        { PHASE_OPAQUE(); CtxChunkOrder CO{G, bx, FF / 256}; EpiResSlab E{WSP(float, WS_SLAB), MVL + 2 * NMODV + 2 * D, 0.5f}; run_gemm_chunk(lds, WSP(bf16, WS_A), WL(WO_DN0), R, D, 256, FF, CO, E); }
        SYNC();
        DBG(11 + 100 * l, 0, 0);
        for (int row = gw; row < R; row += NGW) {
            const float* mv = MVL + (size_t)mid_of_row(row) * NMODV;
            ln_row(XROW(row), c.in(6) + (size_t)l * 3 * D, c.in(7) + (size_t)l * 3 * D, mv + 3 * D, mv + 4 * D, WSP(bf16, WS_H) + (size_t)row * D, lane, row < RL ? 1.0f : ALPHA, WSP(float, WS_SLAB) + (size_t)(row - RL) * D, row < RL ? 0 : FF / 256);
        }
        SYNC();
        DBG(12 + 100 * l, WS_H, (size_t)R * D);
        { SO.init(R, PJ, G, bx); EpiProj E{WSP(bf16, WS_A), WSP(bf16, WS_VT)}; run_gemm(lds, WSP(bf16, WS_H), WL(WO_IN), R, PJ, D, SO, E); }
        SYNC();
        DBG(13 + 100 * l, WS_A, (size_t)R * PJ);
       DBG(14 + 100 * l, WS_VT, (size_t)R * 512);
        {
            const float* rpb = c.in(21) + (size_t)l * 8 * 465;
            for (int i = tid; i < 8 * 465; i += NWAVES * 64) misc[i] = rpb[i] * LOG2E;
            __syncthreads();
            const int natt = 4096 + (l == 0 ? 128 : 0);
            for (int u = gw; u < natt; u += NGW) {
                if (u < 4096) attn_task(c, 0, u >> 11, (u >> 8) & 7, (u >> 1) & 127, u & 1, misc, lane);
                else { const int v = u - 4096; attn_task(c, 1, v >> 6, (v >> 3) & 7, 0, v & 7, misc, lane); }
            }
            for (int t = NGW - 1 - gw; t < 32 * NCH; t += NGW) s5_task<false>(c, l, t / NCH, t % NCH, lds + wave * S5_WAVEB, lane);
            for (int item = gt; item < R * 64; item += NGT) conv_item(c, l, item);
        }
        SYNC();
        DBG(15 + 100 * l, WS_Y3 + (size_t)R * 512 * 2, (size_t)2 * R * 512);
        {
            for (int t = gw; t < 32 * NCH; t += NGW) s5_task<true>(c, l, t / NCH, t % NCH, lds + wave * S5_WAVEB, lane);
            asm volatile("s_waitcnt vmcnt(0) lgkmcnt(0)" ::: "memory");
            __syncthreads();
            PHASE_OPAQUE();
            SO.init(RM, NGATE, G, bx); EpiGates E{WSP(bf16, WS_A)}; run_gemm(lds, WSP(bf16, WS_H), WL(WO_IN) + (size_t)PJ * D, RM, NGATE, D, SO, E);
        }
        SYNC();
        DBG(16 + 100 * l, WS_VT, (size_t)R * 512);
        DBG(17 + 100 * l, WS_A, (size_t)R * PJ);
        { SO.init(RM, 512, G, bx); EpiGlu E{WSP(bf16, WS_VT), WSP(bf16, WS_Y3)}; run_gemm(lds, WSP(bf16, WS_VT), WL(WO_G), RM, 512, 512, SO, E); }
        SYNC();
        DBG(18 + 100 * l, WS_Y3, (size_t)R * 512);
        { BranchOrder BO{G, bx, RM / 64}; EpiBranch E{WSP(bf16, WS_A), WSP(bf16, WS_H)}; run_gemm(lds, WSP(bf16, WS_Y3), WL(WO_G) + (size_t)512 * 512, 3 * R, 3072, 512, BO, E); }
        SYNC();
        DBG(19 + 100 * l, WS_H, (size_t)R * D);
        { SO.init(RL, D, G, bx); float* XL = c.out(); float* XC = WSP(float, WS_XC); EpiRes E{XL, XC, XL, XC, MVL + 5 * D, 1.0f}; run_gemm(lds, WSP(bf16, WS_H), WL(WO_OUT), RL, D, D, SO, E); }
        if (l == 0) { PHASE_OPAQUE(); CtxChunkOrder CO{G, bx, D / 256}; EpiResSlab E{WSP(float, WS_SLAB), MVL + 2 * NMODV + 5 * D, 1.0f}; run_gemm_chunk(lds, WSP(bf16, WS_H), WL(WO_OUT), R, D, 256, D, CO, E); }
        SYNC();
        DBG(20 + 100 * l, 0, 0);
        for (int row = gw; row < RM; row += NGW) {
            const float* mv = MVL + (size_t)mid_of_row(row) * NMODV;
            ln_row(XROW(row), c.in(6) + (size_t)(l * 3 + 1) * D, c.in(7) + (size_t)(l * 3 + 1) * D, mv + 6 * D, mv + 7 * D, WSP(bf16, WS_H) + (size_t)row * D, lane, row < RL ? 1.0f : ALPHA, WSP(float, WS_SLAB) + (size_t)(row - RL) * D, row < RL ? 0 : D / 256);
        }
        SYNC();
        DBG(21 + 100 * l, 0, 0);
        { SO.init(RM, NUP, G, bx); EpiSwiglu E{WSP(bf16, WS_A)}; run_gemm(lds, WSP(bf16, WS_H), WL(WO_UP1), RM, NUP, D, SO, E); }
        SYNC();
        { SO.init(RL, D, G, bx); float* XL = c.out(); float* XC = WSP(float, WS_XC); EpiRes E{XL, XC, XL, XC, MVL + 8 * D, 0.5f}; run_gemm(lds, WSP(bf16, WS_A), WL(WO_DN1), RL, D, FF, SO, E); }
        if (l == 0) { PHASE_OPAQUE(); CtxChunkOrder CO{G, bx, FF / 256}; EpiResSlab E{WSP(float, WS_SLAB), MVL + 2 * NMODV + 8 * D, 0.5f}; run_gemm_chunk(lds, WSP(bf16, WS_A), WL(WO_DN1), R, D, 256, FF, CO, E); }
        SYNC();
        for (int row = gw; row < RM; row += NGW) {
            const float* mv = MVL + 3 * NMODV + (size_t)mid_of_row(row) * NMODV;
            ln_row(XROW(row), c.in(6) + (size_t)(l * 3 + 2) * D, c.in(7) + (size_t)(l * 3 + 2) * D, mv, mv + D, l == 0 ? WSP(bf16, WS_H) + (size_t)row * D : (bf16*)nullptr, lane, row < RL ? 1.0f : ALPHA, WSP(float, WS_SLAB) + (size_t)(row - RL) * D, row < RL ? 0 : FF / 256);
        }
        if (l == 0) SYNC();
    }
}

extern "C" void kernel_launch(void* const* d_in, const int* in_sizes, int n_in, void* d_out, int out_size, void* d_ws, size_t ws_size, hipStream_t stream) {
    static int grid = 0;
    if (grid == 0) {
        if (n_in != 25 || in_sizes[0] != RL * D || out_size != RL * D || ws_size < WS_END) {
            fprintf(stderr, "kernel_launch: unexpected shapes (n_in %d, in0 %d, out %d, ws %zu, need %zu); nothing launched\n", n_in, n_in > 0 ? in_sizes[0] : -1, out_size, ws_size, (size_t)WS_END); grid = -1; return; }
        int dev = 0, cus = 0, per_cu = 0;
        if (hipGetDevice(&dev) != hipSuccess || hipDeviceGetAttribute(&cus, hipDeviceAttributeMultiprocessorCount, dev) != hipSuccess) { grid = -1; return; }
        if (hipFuncSetAttribute((const void*)fwd_megakernel, hipFuncAttributeMaxDynamicSharedMemorySize, LDS_BYTES) != hipSuccess) { fprintf(stderr, "kernel_launch: hipFuncSetAttribute failed\n"); grid = -1; return; }
        if (hipOccupancyMaxActiveBlocksPerMultiprocessor(&per_cu, (const void*)fwd_megakernel, NWAVES * 64, LDS_BYTES) != hipSuccess || per_cu < 1) { fprintf(stderr, "kernel_launch: occupancy query says %d\n", per_cu); grid = -1; return; }
        grid = cus;
    }
    if (grid < 0) return;
    (void)hipMemsetAsync((char*)d_ws + WS_MODV, 0, MODV_ZERO_BYTES, stream);
    Args a{};
    for (int i = 0; i < 25; ++i) a.in[i] = (const float*)d_in[i];
    a.out = (float*)d_out; a.ws = (unsigned char*)d_ws;
    void* args[] = {&a};
    const hipError_t e = hipLaunchCooperativeKernel((const void*)fwd_megakernel, dim3(grid), dim3(NWAVES * 64), args, LDS_BYTES, stream);
    if (e != hipSuccess) fprintf(stderr, "kernel_launch: cooperative launch failed: %s (grid %d)\n", hipGetErrorString(e), grid);
}
```

```cpp
#include <hip/hip_runtime.h>
#include <hip/hip_cooperative_groups.h>
#include <cstdio>
#include <cstdint>
namespace cg = cooperative_groups;

namespace pg8 {
#define PG8_LAS __attribute__((address_space(3)))
typedef unsigned short bf16_t;
typedef short bf16x8 __attribute__((ext_vector_type(8)));
typedef float f32x4 __attribute__((ext_vector_type(4)));
typedef unsigned u32x4 __attribute__((ext_vector_type(4)));
constexpr int BM = 256, BK = 64, HALF = 128, HTB = HALF * BK * 2  , STAGE_BYTES = 8 * HTB, NXCD = 8, WGM = 8;

__host__ __device__ __forceinline__ int lds_byte(int r, int c) { const int st = (r >> 4) * 2 + (c >> 5), rr = r & 15, cc = c & 31, ob = rr * 64 + cc * 2; return st * 1024 + (ob ^ (((ob >> 9) & 1) << 5)); }
__host__ __device__ __forceinline__ void stage_rc(int b, int& R, int& C) { const int st = b / 1024, sb = b % 1024, swz = sb ^ (((sb >> 9) & 1) << 5); R = (st >> 1) * 16 + swz / 64; C = (st & 1) * 32 + (swz % 64) / 2; }
__host__ __device__ __forceinline__ int perm32(int rho) { const int n = rho >> 4, i = rho & 15; return 8 * (i >> 2) + 4 * n + (i & 3); }

struct Unit { int pm, pn, kofs; };
struct Gemm { const bf16_t* A; const bf16_t* Bt; int M, N, K, ld; };

struct StaticOrder {
    int nM, nN, nwg, G, c;
    __host__ __device__ void init(int M, int N, int G_, int c_) { nM = M / BM; nN = N / BM; nwg = nM * nN; G = G_; c = c_; }
    __host__ __device__ bool next(int i, Unit& u) const {
        const long L = (long)i * G + c; if (L >= nwg) return false;
        int wgid = (int)L; { const int q = nwg / NXCD, r = nwg % NXCD, xcd = wgid % NXCD, off = wgid / NXCD; wgid = (xcd < r ? xcd * (q + 1) : r * (q + 1) + (xcd - r) * q) + off; }
        const int nig = WGM * nN, gid = wgid / nig, fm = gid * WGM, gsz = (nM - fm) < WGM ? (nM - fm) : WGM;
        u.pm = fm + ((wgid % nig) % gsz); u.pn = (wgid % nig) / gsz; u.kofs = 0; return true;
    }
    __device__ __forceinline__ void a_ready(const Unit&) const {}
    __device__ __forceinline__ void done(const Unit&) const {}
};
typedef float f32x2_cv __attribute__((ext_vector_type(2))); typedef __bf16 bf16x2_cv __attribute__((ext_vector_type(2)));
__device__ __forceinline__ unsigned cvt_pk_bf16(float lo, float hi) { f32x2_cv v = {lo, hi}; bf16x2_cv b = __builtin_convertvector(v, bf16x2_cv); return __builtin_bit_cast(unsigned, b); }
template <class Epi, class Sched, bool ALIGN_EPI = false, bool SP2 = false>
__device__ __forceinline__ void gemm_phase(PG8_LAS unsigned char* lds, const Gemm g, const Sched& S, const Epi& E) {
    int tid_ = threadIdx.x; asm volatile("" : "+v"(tid_));
    const int tid = tid_, wid = __builtin_amdgcn_readfirstlane(tid >> 6), lane = tid & 63, wr = wid >> 2, wc = wid & 3, fr = lane & 15, fq = lane >> 4;
    const int K = g.K, nt = K / BK;
    unsigned voffA[2], voffB[2];
#pragma unroll
    for (int i = 0; i < 2; ++i) { int R, C; stage_rc(tid * 16 + i * 8192, R, C); const int Rb = Epi::PERM ? ((R & ~31) + perm32(R & 31)) : R;
        voffA[i] = (unsigned)(R * g.ld + C) * 2u; voffB[i] = (unsigned)(Rb * g.ld + C) * 2u; }
    const size_t kstep = (size_t)(BK * 2);
    const size_t hstep = (size_t)HALF * g.ld * 2;
    const size_t tstep = 2 * hstep;
    const unsigned ldsw = (unsigned)wid * 1024u;
    const int aoff = lds_byte(wr * 64 + fr, fq * 8), boff = lds_byte(wc * 32 + fr, fq * 8);
#define PG8_SA(b, h) (((b) * 2 + (h)) * HTB)
#define PG8_SB(b, h) ((4 + (b) * 2 + (h)) * HTB)
#define PG8_STAGE(bufoff, gbase, voff) do { _Pragma("unroll") for (int _i = 0; _i < 2; ++_i) \
        __builtin_amdgcn_global_load_lds((const unsigned*)((const char*)(gbase) + (voff)[_i]), (PG8_LAS unsigned*)(lds + (bufoff) + ldsw + _i * 8192), 16, 0, 0); } while (0)
#define PG8_LDA(dst, b, h) do { _Pragma("unroll") for (int m = 0; m < 4; ++m) _Pragma("unroll") for (int k = 0; k < 2; ++k) dst[m][k] = *(const PG8_LAS bf16x8*)(lds + PG8_SA(b, h) + aoff + m * 2048 + k * 1024); } while (0)
#define PG8_LDB(dst, b, h) do { _Pragma("unroll") for (int n = 0; n < 2; ++n) _Pragma("unroll") for (int k = 0; k < 2; ++k) dst[n][k] = *(const PG8_LAS bf16x8*)(lds + PG8_SB(b, h) + boff + n * 2048 + k * 1024); } while (0)
#define PG8_MMA(ai, bj, At, Bt) do { __builtin_amdgcn_s_setprio(1); _Pragma("unroll") for (int m = 0; m < 4; ++m) _Pragma("unroll") for (int n = 0; n < 2; ++n) _Pragma("unroll") for (int k = 0; k < 2; ++k) \
        acc[ai][bj][m][n] = __builtin_amdgcn_mfma_f32_16x16x32_bf16(Bt[n][k], At[m][k], acc[ai][bj][m][n], 0, 0, 0); __builtin_amdgcn_s_setprio(0); } while (0)
#define PG8_WAIT_V(n) asm volatile("s_waitcnt vmcnt(" #n ")" ::: "memory")
#define PG8_WAIT_L(n) asm volatile("s_waitcnt lgkmcnt(" #n ")" ::: "memory")
#define PG8_BAR __builtin_amdgcn_s_barrier()
#define PG8_SCHED __builtin_amdgcn_sched_barrier(0)
    Unit cur, nxt; int ui = 0;
    if (!S.next(0, cur)) return;
    f32x4 acc[2][2][4][2];
#pragma unroll
    for (int a = 0; a < 2; ++a)
#pragma unroll
        for (int b = 0; b < 2; ++b)
#pragma unroll
            for (int m = 0; m < 4; ++m)
#pragma unroll
                for (int n = 0; n < 2; ++n) acc[a][b][m][n] = (f32x4){0.f, 0.f, 0.f, 0.f};
    bf16x8 At[4][2], B0[2][2], B1[2][2];
    const char* cA = (const char*)g.A + (size_t)cur.pm * tstep + (size_t)cur.kofs * 2; const char* cB = (const char*)g.Bt + (size_t)cur.pn * tstep + (size_t)cur.kofs * 2;
    S.a_ready(cur);
    if constexpr (SP2) {
        PG8_STAGE(PG8_SB(0, 0), cB, voffB); PG8_STAGE(PG8_SB(0, 1), cB + hstep, voffB); PG8_STAGE(PG8_SA(0, 0), cA, voffA); PG8_STAGE(PG8_SA(0, 1), cA + hstep, voffA);
        if (wr == 1) PG8_BAR;
        PG8_WAIT_V(2); PG8_BAR;
        PG8_STAGE(PG8_SB(1, 0), cB + kstep, voffB); PG8_STAGE(PG8_SA(1, 0), cA + kstep, voffA); PG8_STAGE(PG8_SB(1, 1), cB + hstep + kstep, voffB);
        PG8_WAIT_V(6); PG8_BAR;
    } else {
        PG8_STAGE(PG8_SB(0, 0), cB, voffB); PG8_STAGE(PG8_SA(0, 0), cA, voffA); PG8_STAGE(PG8_SB(0, 1), cB + hstep, voffB); PG8_STAGE(PG8_SA(0, 1), cA + hstep, voffA);
        if (wr == 1) PG8_BAR;
        PG8_WAIT_V(4); PG8_BAR;
        PG8_STAGE(PG8_SB(1, 0), cB + kstep, voffB); PG8_STAGE(PG8_SA(1, 0), cA + kstep, voffA); PG8_STAGE(PG8_SB(1, 1), cB + hstep + kstep, voffB);
        PG8_WAIT_V(6); PG8_BAR;
    }
    for (;;) {
        const bool has_next = S.next(ui + 1, nxt);
        const char* nA = has_next ? (const char*)g.A + (size_t)nxt.pm * tstep + (size_t)nxt.kofs * 2 : cA; const char* nB = has_next ? (const char*)g.Bt + (size_t)nxt.pn * tstep + (size_t)nxt.kofs * 2 : cB;
        for (int t = 0; t < nt; t += 2) {
            const bool last = (t == nt - 2);
            const char* a1 = cA + (size_t)(t + 1) * kstep;
            const char* a2 = last ? nA : cA + (size_t)(t + 2) * kstep; const char* b2 = last ? nB : cB + (size_t)(t + 2) * kstep;
            const char* a3 = a2 + kstep; const char* b3 = b2 + kstep;
            if (last && has_next) S.a_ready(nxt);
            if constexpr (SP2) {
            PG8_LDB(B0, 0, 0); PG8_LDB(B1, 0, 1); PG8_SCHED; PG8_LDA(At, 0, 0); PG8_STAGE(PG8_SA(1, 1), a1 + hstep, voffA);
            PG8_WAIT_V(8); PG8_WAIT_L(0); PG8_BAR; PG8_MMA(0, 0, At, B0); PG8_MMA(0, 1, At, B1); PG8_BAR; PG8_SCHED;
            PG8_LDA(At, 0, 1); PG8_STAGE(PG8_SB(0, 0), b2, voffB); PG8_STAGE(PG8_SB(0, 1), b2 + hstep, voffB); PG8_STAGE(PG8_SA(0, 0), a2, voffA);
            PG8_WAIT_V(8); PG8_WAIT_L(0); PG8_BAR; PG8_MMA(1, 0, At, B0); PG8_MMA(1, 1, At, B1); PG8_BAR; PG8_SCHED;
            PG8_LDB(B0, 1, 0); PG8_LDB(B1, 1, 1); PG8_SCHED; PG8_LDA(At, 1, 0); PG8_STAGE(PG8_SA(0, 1), a2 + hstep, voffA);
            PG8_WAIT_V(8); PG8_WAIT_L(0); PG8_BAR; PG8_MMA(0, 0, At, B0); PG8_MMA(0, 1, At, B1); PG8_BAR; PG8_SCHED;
            PG8_LDA(At, 1, 1); PG8_STAGE(PG8_SB(1, 0), b3, voffB); PG8_STAGE(PG8_SB(1, 1), b3 + hstep, voffB); PG8_STAGE(PG8_SA(1, 0), a3, voffA);
            PG8_WAIT_V(8); PG8_WAIT_L(0); PG8_BAR; PG8_MMA(1, 0, At, B0); PG8_MMA(1, 1, At, B1); PG8_BAR; PG8_SCHED;
            } else {
            PG8_LDB(B0, 0, 0); PG8_SCHED; PG8_LDA(At, 0, 0); PG8_STAGE(PG8_SA(1, 1), a1 + hstep, voffA);
            PG8_WAIT_L(8); PG8_BAR; PG8_WAIT_L(0); PG8_MMA(0, 0, At, B0); PG8_BAR; PG8_SCHED;
            PG8_LDB(B1, 0, 1); PG8_STAGE(PG8_SB(0, 0), b2, voffB);
            PG8_BAR; PG8_WAIT_L(0); PG8_MMA(0, 1, At, B1); PG8_BAR;
            PG8_LDA(At, 0, 1); PG8_STAGE(PG8_SA(0, 0), a2, voffA);
            PG8_BAR; PG8_WAIT_L(0); PG8_MMA(1, 0, At, B0); PG8_BAR; PG8_SCHED;
            PG8_STAGE(PG8_SB(0, 1), b2 + hstep, voffB);
            PG8_WAIT_V(6); PG8_BAR; PG8_MMA(1, 1, At, B1); PG8_BAR;
            PG8_LDB(B0, 1, 0); PG8_SCHED; PG8_LDA(At, 1, 0); PG8_STAGE(PG8_SA(0, 1), a2 + hstep, voffA);
            PG8_WAIT_L(8); PG8_BAR; PG8_WAIT_L(0); PG8_MMA(0, 0, At, B0); PG8_BAR; PG8_SCHED;
            PG8_LDB(B1, 1, 1); PG8_STAGE(PG8_SB(1, 0), b3, voffB);
            PG8_BAR; PG8_WAIT_L(0); PG8_MMA(0, 1, At, B1); PG8_BAR;
            PG8_LDA(At, 1, 1); PG8_STAGE(PG8_SA(1, 0), a3, voffA);
            PG8_BAR; PG8_WAIT_L(0); PG8_MMA(1, 0, At, B0); PG8_BAR; PG8_SCHED;
            PG8_STAGE(PG8_SB(1, 1), b3 + hstep, voffB);
            PG8_WAIT_V(6); PG8_BAR; PG8_MMA(1, 1, At, B1); PG8_BAR;
            }
        }
        if constexpr (ALIGN_EPI) { if (wr == 0) PG8_BAR; }
        if constexpr (!Epi::AFTER_DRAIN) { E(acc, cur, wr, wc, fr, fq); S.done(cur); }
        if (!has_next) break;
#pragma unroll
        for (int a = 0; a < 2; ++a)
#pragma unroll
            for (int b = 0; b < 2; ++b)
#pragma unroll
                for (int m = 0; m < 4; ++m)
#pragma unroll
                    for (int n = 0; n < 2; ++n) acc[a][b][m][n] = (f32x4){0.f, 0.f, 0.f, 0.f};
        cur = nxt; cA = nA; cB = nB; ++ui;
        if constexpr (ALIGN_EPI) { if (wr == 1) PG8_BAR; }
    }
    PG8_WAIT_V(0);
    if constexpr (!ALIGN_EPI) { if (wr == 0) PG8_BAR; }
    PG8_BAR;
    if constexpr (Epi::AFTER_DRAIN) { E.fused(acc, cur, wr, wc, fr, fq, lds, wid, lane); S.done(cur); }
#undef PG8_SA
#undef PG8_SB
#undef PG8_STAGE
#undef PG8_LDA
#undef PG8_LDB
#undef PG8_MMA
#undef PG8_WAIT_V
#undef PG8_WAIT_L
#undef PG8_BAR
#undef PG8_SCHED
}
}

#define GAS __attribute__((address_space(1)))
#define LAS __attribute__((address_space(3)))
typedef unsigned short bf16;
typedef unsigned v4u __attribute__((ext_vector_type(4)));
typedef unsigned v2u __attribute__((ext_vector_type(2)));
typedef float f32x4 __attribute__((ext_vector_type(4)));
typedef float f32x16 __attribute__((ext_vector_type(16)));
typedef short bf16x8 __attribute__((ext_vector_type(8)));

constexpr int D = 1024, SEQ = 8192, CTXL = 256, RL = 16384, RC = 512, R = RL + RC, FF = 2816, NUP = 2 * FF;
constexpr int PJ = 3584;
constexpr int DIN = 6656, NGATE = 3072;
constexpr int COL_U = 0, COL_K = 512, COL_V = 1024, COL_Q = 1536, COL_Z = 2048, COL_B = 2560, COL_C = 3072;
constexpr int TOKP = SEQ + CTXL;
constexpr int NMODV = 9 * D;
constexpr float LN_EPS = 1e-5f;
constexpr float ALPHA = 1.4142135623730951f;
constexpr int NCH = 66;
constexpr int NWAVES = 8;

constexpr size_t KiB = 1024, MiB = 1024 * 1024;
constexpr size_t WS_MODV = 0, MODV_ZERO_BYTES = 256 * KiB;
constexpr size_t WS_BAR = 221184;
constexpr size_t WS_LAM = 256 * KiB, WS_LAML = 320 * KiB;
constexpr size_t WS_PTRS = 384 * KiB;
constexpr size_t WS_BB = 1 * MiB;
constexpr size_t WS_CT = 2 * MiB;
constexpr size_t WS_E = 3 * MiB;
constexpr size_t WS_W = 8 * MiB;
constexpr size_t WB_UP = (size_t)NUP * D * 2, WB_DN = (size_t)D * FF * 2, WB_IN = (size_t)DIN * D * 2, WB_G = (size_t)(512 + 3072) * 512 * 2, WB_OUT = (size_t)D * D * 2;
constexpr size_t WO_UP0 = 0, WO_UP1 = WB_UP, WO_DN0 = 2 * WB_UP, WO_DN1 = WO_DN0 + WB_DN, WO_IN = WO_DN1 + WB_DN, WO_G = WO_IN + WB_IN, WO_OUT = WO_G + WB_G, WL_BYTES = WO_OUT + WB_OUT;
constexpr size_t WS_XC = WS_W + 2 * WL_BYTES;
constexpr size_t WS_A = WS_XC + (size_t)RC * D * 4;
constexpr size_t WS_SLAB = WS_A + (size_t)R * FF * 2;
static_assert(WS_SLAB % 256 == 0 && WS_SLAB + (size_t)11 * RC * D * 4 <= WS_A + (size_t)R * PJ * 2, "slab fits behind ACT");
constexpr size_t WS_Y3 = WS_A + (size_t)R * PJ * 2;
constexpr size_t WS_H = WS_Y3 + (size_t)3 * R * 512 * 2;
constexpr size_t WS_VT = WS_H + (size_t)R * D * 2;
constexpr size_t WS_END = WS_VT + (size_t)R * 512 * 2;
static_assert(WS_E + (size_t)2 * 32 * NCH * 2 * 64 * 2 * 4 <= WS_W, "E fits");
static_assert((size_t)2 * 3 * 9 * 1024 * 4 <= WS_BAR && WS_BAR + 3456 * 4 <= MODV_ZERO_BYTES, "barrier words inside the zeroed region");
static_assert(WS_W % 256 == 0 && WL_BYTES % 256 == 0 && WS_A % 256 == 0 && WS_Y3 % 256 == 0 && WS_H % 256 == 0 && WS_VT % 256 == 0, "alignment");

constexpr int LDS_BYTES = 131072 + 16384;

__device__ __forceinline__ unsigned f2bf(float f) { unsigned u = __builtin_bit_cast(unsigned, f); return (u + 0x7fffu + ((u >> 16) & 1u)) >> 16; }
__device__ __forceinline__ unsigned pk2(float lo, float hi) { return pg8::cvt_pk_bf16(lo, hi); }
__device__ __forceinline__ float bf2f(unsigned short b) { return __builtin_bit_cast(float, (unsigned)b << 16); }
__device__ __forceinline__ float bflo(unsigned w) { return __builtin_bit_cast(float, w << 16); }
__device__ __forceinline__ float bfhi(unsigned w) { return __builtin_bit_cast(float, w & 0xffff0000u); }
__device__ __forceinline__ float sigmoidf_(float x) { return __builtin_amdgcn_rcpf(1.0f + __expf(-x)); }
__device__ __forceinline__ float siluf_(float x) { return x * sigmoidf_(x); }
__device__ __forceinline__ float gelu_tanh(float x) { const float u = 0.7978845608028654f * (x + 0.044715f * x * x * x); return x * sigmoidf_(2.0f * u); }
__device__ __forceinline__ float wave_sum(float v) {
#pragma unroll
    for (int o = 1; o < 64; o <<= 1) v += __shfl_xor(v, o);
    return v;
}
__device__ __forceinline__ int mid_of_row(int row) { return row < RL ? (row >> 13) : 2; }

using pg8::Unit;
struct EpiSwiglu {
    static constexpr bool PERM = true, AFTER_DRAIN = false;
    bf16* O;
    __device__ __forceinline__ void operator()(const f32x4 (&acc)[2][2][4][2], const Unit& u, int wr, int wc, int fr, int fq) const {
        const int row0 = u.pm * 256 + wr * 64 + fr, col0 = u.pn * 128 + wc * 32 + 8 * fq;
#pragma unroll
        for (int ai = 0; ai < 2; ++ai)
#pragma unroll
            for (int m = 0; m < 4; ++m) {
                bf16* rowp = O + (size_t)(row0 + ai * 128 + m * 16) * FF + col0;
                const f32x4 g0 = acc[ai][0][m][0], g1 = acc[ai][0][m][1], u0 = acc[ai][1][m][0], u1 = acc[ai][1][m][1];
                v4u w;
                w.x = pk2(siluf_(g0[0]) * u0[0], siluf_(g0[1]) * u0[1]); w.y = pk2(siluf_(g0[2]) * u0[2], siluf_(g0[3]) * u0[3]);
                w.z = pk2(siluf_(g1[0]) * u1[0], siluf_(g1[1]) * u1[1]); w.w = pk2(siluf_(g1[2]) * u1[2], siluf_(g1[3]) * u1[3]);
                *(v4u*)rowp = w;
            }
    }
};
struct EpiRes {
    static constexpr bool PERM = false, AFTER_DRAIN = false;
    const float* xin_lat; const float* xin_ctx; float* xout_lat; float* xout_ctx; const float* gate  ; float coef;
    __device__ __forceinline__ void operator()(const f32x4 (&acc)[2][2][4][2], const Unit& u, int wr, int wc, int fr, int fq) const {
        const bool lat = u.pm < 64;
        const float* xin = lat ? xin_lat + (size_t)u.pm * 256 * D : xin_ctx + (size_t)(u.pm - 64) * 256 * D;
        float* xout = lat ? xout_lat + (size_t)u.pm * 256 * D : xout_ctx + (size_t)(u.pm - 64) * 256 * D;
        const int mid = lat ? (u.pm >> 5) : 2;
        const int col0 = u.pn * 256 + wc * 32 + 4 * fq;
        const float* gp = gate + (size_t)mid * NMODV + col0;
#pragma unroll
        for (int bj = 0; bj < 2; ++bj)
#pragma unroll
            for (int n = 0; n < 2; ++n) {
                const f32x4 gv = *(const f32x4*)(gp + bj * 128 + n * 16) * coef;
#pragma unroll
                for (int ai = 0; ai < 2; ++ai)
#pragma unroll
                    for (int m = 0; m < 4; ++m) {
                        const size_t off = (size_t)(ai * 128 + wr * 64 + m * 16 + fr) * D + col0 + bj * 128 + n * 16;
                        const f32x4 xi = *(const f32x4*)(xin + off);
                        *(f32x4*)(xout + off) = xi * ALPHA + gv * acc[ai][bj][m][n];
                        asm volatile("" ::: "memory");
                    }
            }
    }
};
struct EpiProj {
    static constexpr bool PERM = true, AFTER_DRAIN = false;
    bf16* P; bf16* VT;
    __device__ __forceinline__ void operator()(const f32x4 (&acc)[2][2][4][2], const Unit& u, int wr, int wc, int fr, int fq) const {
        const int row0 = u.pm * 256 + wr * 64 + fr, col0 = u.pn * 256 + wc * 32 + 8 * fq;
        if (u.pn == 4 || u.pn == 5) {
#pragma unroll
            for (int ai = 0; ai < 2; ++ai)
#pragma unroll
                for (int m = 0; m < 4; ++m) {
                    const int row = row0 + ai * 128 + m * 16;
                    int b, tok; if (row < RL) { b = row >> 13; tok = row & 8191; } else { b = (row - RL) >> 8; tok = SEQ + ((row - RL) & 255); }
#pragma unroll
                    for (int bj = 0; bj < 2; ++bj)
#pragma unroll
                        for (int n = 0; n < 2; ++n)
#pragma unroll
                            for (int e = 0; e < 4; ++e) {
                                const int vc = col0 + bj * 128 + 4 * n + e - COL_V;
                                VT[((size_t)(b * 512 + vc)) * TOKP + tok] = (bf16)f2bf(acc[ai][bj][m][n][e]);
                            }
                }
        } else {
#pragma unroll
            for (int ai = 0; ai < 2; ++ai)
#pragma unroll
                for (int m = 0; m < 4; ++m) {
                    bf16* rowp = P + (size_t)(row0 + ai * 128 + m * 16) * PJ + col0;
#pragma unroll
                    for (int bj = 0; bj < 2; ++bj) {
                        const f32x4 v0 = acc[ai][bj][m][0], v1 = acc[ai][bj][m][1];
                        v4u w; w.x = pk2(v0[0], v0[1]); w.y = pk2(v0[2], v0[3]); w.z = pk2(v1[0], v1[1]); w.w = pk2(v1[2], v1[3]);
                        *(v4u*)(rowp + bj * 128) = w;
                    }
                }
        }
    }
};
struct EpiGates {
    static constexpr bool PERM = true, AFTER_DRAIN = false;
    bf16* P;
    __device__ __forceinline__ void operator()(const f32x4 (&acc)[2][2][4][2], const Unit& u, int wr, int wc, int fr, int fq) const {
        const int row0 = u.pm * 256 + wr * 64 + fr, col0 = 512 + u.pn * 256 + wc * 32 + 8 * fq;
#pragma unroll
        for (int ai = 0; ai < 2; ++ai)
#pragma unroll
            for (int m = 0; m < 4; ++m) {
                bf16* rowp = P + (size_t)(row0 + ai * 128 + m * 16) * PJ + col0;
#pragma unroll
                for (int bj = 0; bj < 2; ++bj) {
                    const f32x4 v0 = acc[ai][bj][m][0], v1 = acc[ai][bj][m][1];
                    v4u w; w.x = pk2(sigmoidf_(v0[0]), sigmoidf_(v0[1])); w.y = pk2(sigmoidf_(v0[2]), sigmoidf_(v0[3]));
                    w.z = pk2(sigmoidf_(v1[0]), sigmoidf_(v1[1])); w.w = pk2(sigmoidf_(v1[2]), sigmoidf_(v1[3]));
                    *(v4u*)(rowp + bj * 128) = w;
                }
            }
    }
};
struct EpiGlu {
    static constexpr bool PERM = true, AFTER_DRAIN = false;
    const bf16* GA; bf16* YA;
    __device__ __forceinline__ void operator()(const f32x4 (&acc)[2][2][4][2], const Unit& u, int wr, int wc, int fr, int fq) const {
        const int row0 = u.pm * 256 + wr * 64 + fr, col0 = u.pn * 256 + wc * 32 + 8 * fq;
#pragma unroll
        for (int ai = 0; ai < 2; ++ai)
#pragma unroll
            for (int m = 0; m < 4; ++m) {
                const size_t ro = (size_t)(row0 + ai * 128 + m * 16) * 512 + col0;
#pragma unroll
                for (int bj = 0; bj < 2; ++bj) {
                    const v4u gin = *(const v4u*)(GA + ro + bj * 128);
                    const f32x4 v0 = acc[ai][bj][m][0], v1 = acc[ai][bj][m][1];
                    v4u w;
                    w.x = pk2(bflo(gin.x) * sigmoidf_(v0[0]), bfhi(gin.x) * sigmoidf_(v0[1])); w.y = pk2(bflo(gin.y) * sigmoidf_(v0[2]), bfhi(gin.y) * sigmoidf_(v0[3]));
                    w.z = pk2(bflo(gin.z) * sigmoidf_(v1[0]), bfhi(gin.z) * sigmoidf_(v1[1])); w.w = pk2(bflo(gin.w) * sigmoidf_(v1[2]), bfhi(gin.w) * sigmoidf_(v1[3]));
                    *(v4u*)(YA + ro + bj * 128) = w;
                }
                asm volatile("" ::: "memory");
            }
    }
};
struct EpiBranch {
    static constexpr bool PERM = true, AFTER_DRAIN = false;
    const bf16* P; bf16* MM;
    __device__ __forceinline__ void operator()(const f32x4 (&acc)[2][2][4][2], const Unit& u, int wr, int wc, int fr, int fq) const {
        const int b = u.pn >> 2, pn = u.pn & 3, pm = u.pm - 66 * b;
        const int row0 = pm * 256 + wr * 64 + fr, col0 = pn * 256 + wc * 32 + 8 * fq;
#pragma unroll
        for (int ai = 0; ai < 2; ++ai)
#pragma unroll
            for (int m = 0; m < 4; ++m) {
                const int row = row0 + ai * 128 + m * 16;
                const bf16* gp = P + (size_t)row * PJ + 512 + b * 1024 + col0;
                bf16* mp = MM + (size_t)row * D + col0;
#pragma unroll
                for (int bj = 0; bj < 2; ++bj) {
                    const v4u gin = *(const v4u*)(gp + bj * 128);
                    const f32x4 v0 = acc[ai][bj][m][0], v1 = acc[ai][bj][m][1];
                    float o[8] = {bflo(gin.x) * v0[0], bfhi(gin.x) * v0[1], bflo(gin.y) * v0[2], bfhi(gin.y) * v0[3], bflo(gin.z) * v1[0], bfhi(gin.z) * v1[1], bflo(gin.w) * v1[2], bfhi(gin.w) * v1[3]};
                    if (b != 0) {
                        const unsigned long long* mq = (const unsigned long long*)(mp + bj * 128);
                        const unsigned long long q0 = __hip_atomic_load(mq, __ATOMIC_RELAXED, __HIP_MEMORY_SCOPE_AGENT), q1 = __hip_atomic_load(mq + 1, __ATOMIC_RELAXED, __HIP_MEMORY_SCOPE_AGENT);
                        v4u pv; pv.x = (unsigned)q0; pv.y = (unsigned)(q0 >> 32); pv.z = (unsigned)q1; pv.w = (unsigned)(q1 >> 32);
                        o[0] += bflo(pv.x); o[1] += bfhi(pv.x); o[2] += bflo(pv.y); o[3] += bfhi(pv.y); o[4] += bflo(pv.z); o[5] += bfhi(pv.z); o[6] += bflo(pv.w); o[7] += bfhi(pv.w); }
                    v4u w; w.x = pk2(o[0], o[1]); w.y = pk2(o[2], o[3]); w.z = pk2(o[4], o[5]); w.w = pk2(o[6], o[7]);
                    *(v4u*)(mp + bj * 128) = w;
                }
                asm volatile("" ::: "memory");
            }
    }
};
struct BranchOrder {
    int G, c, ntile;
    __device__ bool next(int i, Unit& u) const {
        const int T = (i / 3) * G + c, b = i % 3; if (T >= ntile) return false;
        const int pm = T >> 2, pn = T & 3; u.pm = 66 * b + pm; u.pn = 4 * b + pn; u.kofs = 0; return true;
    }
    __device__ __forceinline__ void a_ready(const Unit&) const {}
    __device__ __forceinline__ void done(const Unit&) const {}
};

struct CtxChunkOrder {
    int G, c, nchunk;
    __device__ bool next(int i, Unit& u) const {
        const int L = i * G + c; if (L >= 8 * nchunk) return false;
        const int tile = L & 7, ch = L >> 3; u.pm = 64 + (tile >> 2); u.pn = tile & 3; u.kofs = ch * 256; return true;
    }
    __device__ __forceinline__ void a_ready(const Unit&) const {}
    __device__ __forceinline__ void done(const Unit&) const {}
};
struct EpiResSlab {
    static constexpr bool PERM = false, AFTER_DRAIN = false;
    float* slab; const float* gate  ; float coef;
    __device__ __forceinline__ void operator()(const f32x4 (&acc)[2][2][4][2], const Unit& u, int wr, int wc, int fr, int fq) const {
        const int col0 = u.pn * 256 + wc * 32 + 4 * fq;
        float* pbase = slab + ((size_t)(u.kofs >> 8) * RC + (size_t)(u.pm - 64) * 256 + wr * 64 + fr) * D + col0;
#pragma unroll
        for (int ai = 0; ai < 2; ++ai)
#pragma unroll
            for (int m = 0; m < 4; ++m) {
                float* p = pbase + (ai * 128 + m * 16) * D;
#pragma unroll
                for (int bj = 0; bj < 2; ++bj)
#pragma unroll
                    for (int n = 0; n < 2; ++n) *(f32x4*)(p + bj * 128 + n * 16) = *(const f32x4*)(gate + col0 + bj * 128 + n * 16) * coef * acc[ai][bj][m][n];
                asm volatile("" ::: "memory");
            }
    }
};

__device__ __forceinline__ void transpose_item(const float* Wsrc  , int N, bf16* dst, int ldk, LAS float* scr, int lane) {
#pragma unroll 8
    for (int i = 0; i < 32; ++i) { const int kk = 2 * i + (lane >> 5); scr[kk * 33 + (lane & 31)] = Wsrc[(size_t)kk * N + (lane & 31)]; }
    asm volatile("s_waitcnt lgkmcnt(0)" ::: "memory");
    const int c = lane & 7;
#pragma unroll
    for (int j = 0; j < 4; ++j) { const int n = (lane >> 3) + 8 * j; const LAS float* s = scr + (8 * c) * 33 + n;
        v4u o; o.x = pk2(s[0 * 33], s[1 * 33]); o.y = pk2(s[2 * 33], s[3 * 33]); o.z = pk2(s[4 * 33], s[5 * 33]); o.w = pk2(s[6 * 33], s[7 * 33]);
        *(v4u*)(dst + (size_t)n * ldk + 8 * c) = o; }
    asm volatile("s_waitcnt lgkmcnt(0)" ::: "memory");
}

struct Args {
    const float* in[25]; float* out; unsigned char* ws;
};
struct Ctx {
    unsigned char* ws;
    __device__ __forceinline__ const float* in(int i) const { return ((const float* const*)(ws + WS_PTRS))[i]; }
    __device__ __forceinline__ float* out() const { return ((float* const*)(ws + WS_PTRS))[25]; }
};

constexpr int IT_UP = 16 * 88, IT_DN = 44 * 32, IT_IN = 16 * 208, IT_GLU = 8 * 16, IT_BR = 8 * 32, IT_OUT = 16 * 32;
constexpr int IT_LAYER = 4 * IT_UP + 2 * IT_DN + IT_IN + IT_GLU + 3 * IT_BR + IT_OUT;

__device__ __forceinline__ void convert_item(const Args& a, int it, LAS float* scr, int lane) {
    const int l = it / IT_LAYER; int r = it % IT_LAYER;
    unsigned char* wl = a.ws + WS_W + (size_t)l * WL_BYTES;
    if (r < 4 * IT_UP) {
        const int which = r / IT_UP, s = which >> 1, isu = which & 1; r %= IT_UP;
        const int kb = r / 88, nb = r % 88, k0 = 64 * kb, n0 = 32 * nb;
        const float* src = a.in[isu ? 9 : 8] + ((size_t)(l * 2 + s) * D + k0) * FF + n0;
        bf16* dst = (bf16*)(wl + (s ? WO_UP1 : WO_UP0)) + (size_t)(256 * (n0 >> 7) + (n0 & 127) + 128 * isu) * D + k0;
        transpose_item(src, FF, dst, D, scr, lane); return;
    }
    r -= 4 * IT_UP;
    if (r < 2 * IT_DN) {
        const int s = r / IT_DN; r %= IT_DN;
        const int kb = r / 32, nb = r % 32, k0 = 64 * kb, n0 = 32 * nb;
        const float* src = a.in[10] + ((size_t)(l * 2 + s) * FF + k0) * D + n0;
        bf16* dst = (bf16*)(wl + (s ? WO_DN1 : WO_DN0)) + (size_t)n0 * FF + k0;
        transpose_item(src, D, dst, FF, scr, lane); return;
    }
    r -= 2 * IT_DN;
    if (r < IT_IN) {
        const int kb = r / 208, nb = r % 208, k0 = 64 * kb, n0 = 32 * nb;
        const float* src = a.in[11] + ((size_t)l * D + k0) * DIN + n0;
        bf16* dst = (bf16*)(wl + WO_IN) + (size_t)n0 * D + k0;
        transpose_item(src, DIN, dst, D, scr, lane); return;
    }
    r -= IT_IN;
    if (r < IT_GLU) {
        const int kb = r / 16, nb = r % 16, k0 = 64 * kb, n0 = 32 * nb;
        const float* src = a.in[20] + ((size_t)l * 512 + k0) * 512 + n0;
        bf16* dst = (bf16*)(wl + WO_G) + (size_t)n0 * 512 + k0;
        transpose_item(src, 512, dst, 512, scr, lane); return;
    }
    r -= IT_GLU;
    if (r < 3 * IT_BR) {
        const int b = r / IT_BR; r %= IT_BR;
        const int kb = r / 32, nb = r % 32, k0 = 64 * kb, n0 = 32 * nb;
        const float* src = a.in[23] + ((size_t)(l * 3 + b) * 512 + k0) * D + n0;
        bf16* dst = (bf16*)(wl + WO_G) + (size_t)(512 + b * 1024 + n0) * 512 + k0;
        transpose_item(src, D, dst, 512, scr, lane); return;
    }
    r -= 3 * IT_BR;
    {
        const int kb = r / 32, nb = r % 32, k0 = 64 * kb, n0 = 32 * nb;
        const float* src = a.in[24] + ((size_t)l * D + k0) * D + n0;
        bf16* dst = (bf16*)(wl + WO_OUT) + (size_t)n0 * D + k0;
        transpose_item(src, D, dst, D, scr, lane);
    }
}

__device__ __forceinline__ void s5_tables(const Args& a, int idx) {
    const int p = idx & 63, g = (idx >> 6) & 31, dir = (idx >> 11) & 1, l = idx >> 12;
    const int ldg = (l * 2 + dir) * 32 + g;
    const double lr = (double)a.in[12][ldg * 64 + p], li = (double)a.in[13][ldg * 64 + p];
    const double dt = exp((double)a.in[14][ldg]);
    const double mag = exp(lr * dt); double sn, cs; sincos(li * dt, &sn, &cs);
    const double ar = mag * cs, ai = mag * sn;
    float* lam = (float*)(a.ws + WS_LAM); float* lamL = (float*)(a.ws + WS_LAML);
    lam[(ldg * 64 + p) * 2] = (float)ar; lam[(ldg * 64 + p) * 2 + 1] = (float)ai;
    double pr = ar, pi = ai;
#pragma unroll
    for (int i = 0; i < 7; ++i) { const double nr = pr * pr - pi * pi, ni = 2.0 * pr * pi; pr = nr; pi = ni; }
    lamL[(ldg * 64 + p) * 2] = (float)pr; lamL[(ldg * 64 + p) * 2 + 1] = (float)pi;
    const double den = lr * lr + li * li, nr = ar - 1.0, ni = ai;
    const double cr = (nr * lr + ni * li) / den, ci = (ni * lr - nr * li) / den;
    bf16* BB = (bf16*)(a.ws + WS_BB);
    const float* bre = a.in[15] + ((size_t)ldg * 64 + p) * 16; const float* bim = a.in[16] + ((size_t)ldg * 64 + p) * 16;
#pragma unroll
    for (int i = 0; i < 16; ++i) {
        const double br = bre[i], bi = bim[i];
        BB[(((size_t)ldg * 2 + 0) * 64 + p) * 16 + i] = (bf16)f2bf((float)(cr * br - ci * bi));
        BB[(((size_t)ldg * 2 + 1) * 64 + p) * 16 + i] = (bf16)f2bf((float)(cr * bi + ci * br));
    }
    bf16* CT = (bf16*)(a.ws + WS_CT);
    const float* cre = a.in[17] + (size_t)ldg * 16 * 64; const float* cim = a.in[18] + (size_t)ldg * 16 * 64;
#pragma unroll
    for (int h = 0; h < 16; ++h) {
        CT[((size_t)ldg * 16 + h) * 128 + 2 * p] = (bf16)f2bf(cre[h * 64 + p]);
        CT[((size_t)ldg * 16 + h) * 128 + 2 * p + 1] = (bf16)f2bf(-cim[h * 64 + p]);
    }
}

__device__ __forceinline__ void mod_row(const float* xrow, const float* shift, const float* scale, bf16* hrow, int lane) {
    const f32x4* xr = (const f32x4*)xrow + lane; const f32x4* sh = (const f32x4*)shift + lane; const f32x4* sc = (const f32x4*)scale + lane;
    unsigned long long* o8 = (unsigned long long*)hrow + lane;
#pragma unroll
    for (int j = 0; j < 4; ++j) { const f32x4 v = xr[64 * j] * (sc[64 * j] + 1.0f) + sh[64 * j];
        o8[64 * j] = (unsigned long long)pk2(v[0], v[1]) | ((unsigned long long)pk2(v[2], v[3]) << 32); }
}
__device__ __forceinline__ void ln_row(float* xrow, const float* g, const float* b, const float* shift, const float* scale, bf16* hrow, int lane, float oscale, const float* slab_row, int nslab) {
    f32x4* xr = (f32x4*)xrow + lane;
    f32x4 v[4]; float s = 0.f;
#pragma unroll
    for (int j = 0; j < 4; ++j) v[j] = xr[64 * j];
    for (int k = 0; k < nslab; ++k) { const f32x4* sp = (const f32x4*)(slab_row + (size_t)k * RC * D) + lane;
#pragma unroll
        for (int j = 0; j < 4; ++j) v[j] += sp[64 * j]; }
#pragma unroll
    for (int j = 0; j < 4; ++j) s += (v[j][0] + v[j][1]) + (v[j][2] + v[j][3]);
    const float mean = wave_sum(s) * (1.f / D); float s2 = 0.f;
#pragma unroll
    for (int j = 0; j < 4; ++j) { v[j] = v[j] - mean; s2 += (v[j][0] * v[j][0] + v[j][1] * v[j][1]) + (v[j][2] * v[j][2] + v[j][3] * v[j][3]); }
    const float rstd = 1.f / sqrtf(wave_sum(s2) * (1.f / D) + LN_EPS);
    const f32x4* gg = (const f32x4*)g + lane; const f32x4* bb = (const f32x4*)b + lane;
#pragma unroll
    for (int j = 0; j < 4; ++j) { v[j] = v[j] * rstd * gg[64 * j] + bb[64 * j]; xr[64 * j] = v[j] * oscale; }
    if (hrow) {
        const f32x4* sh = (const f32x4*)shift + lane; const f32x4* sc = (const f32x4*)scale + lane;
        unsigned long long* o8 = (unsigned long long*)hrow + lane;
#pragma unroll
        for (int j = 0; j < 4; ++j) { const f32x4 w = v[j] * (sc[64 * j] + 1.0f) + sh[64 * j];
            o8[64 * j] = (unsigned long long)pk2(w[0], w[1]) | ((unsigned long long)pk2(w[2], w[3]) << 32); }
    }
}

#define MFMA32(a, b, c) __builtin_amdgcn_mfma_f32_32x32x16_bf16((a), (b), (c), 0, 0, 0)
#define MFMA16(a, b, c) __builtin_amdgcn_mfma_f32_16x16x32_bf16((a), (b), (c), 0, 0, 0)
constexpr int S5_ROWB = 272, S5_BATB = 16 * S5_ROWB, S5_WAVEB = 2 * S5_BATB;

template <bool PASS2>
__device__ __forceinline__ void s5_task(const Ctx& a, int l, int g, int ch, LAS unsigned char* wl, int lane) {
    const int j = lane & 31, hl = lane >> 5;
    const bf16* P = (const bf16*)(a.ws + WS_A);
    const float* LAM = (const float*)(a.ws + WS_LAM); const float* LAML = (const float*)(a.ws + WS_LAML);
    const bf16* BB = (const bf16*)(a.ws + WS_BB); const bf16* CT = (const bf16*)(a.ws + WS_CT);
    float* E = (float*)(a.ws + WS_E);
    const int rb0 = ch < 2 ? RL + 128 * ch : 128 * (ch - 2), rbstep = ch < 2 ? CTXL : SEQ;
    const int arow = rb0 + ((j >> 2) & 1) * rbstep + 4 * (j >> 3) + (j & 3);
    const bf16* ap = P + (size_t)arow * PJ + COL_U + g * 16 + 8 * hl;
    f32x4 yacc[8][2];
    if (PASS2) {
#pragma unroll
        for (int sb = 0; sb < 8; ++sb) { yacc[sb][0] = (f32x4){0.f, 0.f, 0.f, 0.f}; yacc[sb][1] = (f32x4){0.f, 0.f, 0.f, 0.f}; }
    }
    const f32x16 zero16 = {0.f, 0.f, 0.f, 0.f, 0.f, 0.f, 0.f, 0.f, 0.f, 0.f, 0.f, 0.f, 0.f, 0.f, 0.f, 0.f};
    bf16x8 ufa[8];
    if (PASS2) {
#pragma unroll
        for (int sb = 0; sb < 8; ++sb) ufa[sb] = *(const bf16x8*)(ap + (size_t)(16 * sb) * PJ);
    }
#pragma unroll
    for (int dir = 0; dir < 2; ++dir) {
        const int ldg = (l * 2 + dir) * 32 + g;
        float lr[2], li[2], sr[2], si[2];
#pragma unroll
        for (int ph = 0; ph < 2; ++ph) { lr[ph] = LAM[(ldg * 64 + j + 32 * ph) * 2]; li[ph] = LAM[(ldg * 64 + j + 32 * ph) * 2 + 1]; sr[ph] = 0.f; si[ph] = 0.f; }
        if (PASS2) {
            float Lr[2], Li[2];
#pragma unroll
            for (int ph = 0; ph < 2; ++ph) { Lr[ph] = LAML[(ldg * 64 + j + 32 * ph) * 2]; Li[ph] = LAML[(ldg * 64 + j + 32 * ph) * 2 + 1]; }
            const float* Eb = E + ((size_t)((dir * 32 + g) * NCH) * 2 + hl) * 128 + 2 * j;
            const int cnt = dir == 0 ? ch : (ch == 1 ? 0 : (ch == 0 ? 1 : 2 + (NCH - 1 - ch)));
            typedef float f32x2_t __attribute__((ext_vector_type(2)));
#pragma unroll 1
            for (int k0 = 0; k0 < cnt; k0 += 8) {
                f32x2_t ev[8][2];
#pragma unroll
                for (int q = 0; q < 8; ++q) { const int k = min(k0 + q, cnt - 1); const int cp = dir == 0 ? k : (k == 0 ? 1 : (k == 1 ? 0 : NCH + 1 - k));
                    ev[q][0] = *(const f32x2_t*)(Eb + (size_t)cp * 256); ev[q][1] = *(const f32x2_t*)(Eb + (size_t)cp * 256 + 64); }
#pragma unroll
                for (int q = 0; q < 8; ++q) if (k0 + q < cnt) {
#pragma unroll
                    for (int ph = 0; ph < 2; ++ph) { const float nr = Lr[ph] * sr[ph] - Li[ph] * si[ph] + ev[q][ph][0], ni = Lr[ph] * si[ph] + Li[ph] * sr[ph] + ev[q][ph][1]; sr[ph] = nr; si[ph] = ni; }
                }
            }
        }
        bf16x8 bfr[2][2];
#pragma unroll
        for (int ph = 0; ph < 2; ++ph)
#pragma unroll
            for (int ri = 0; ri < 2; ++ri) bfr[ph][ri] = *(const bf16x8*)(BB + (((size_t)ldg * 2 + ri) * 64 + j + 32 * ph) * 16 + 8 * hl);
        bf16x8 cfr[4];
        if (PASS2) {
#pragma unroll
            for (int ks = 0; ks < 4; ++ks) cfr[ks] = *(const bf16x8*)(CT + ((size_t)ldg * 16 + (lane & 15)) * 128 + 32 * ks + 8 * (lane >> 4));
        }
#pragma unroll
        for (int q = 0; q < (PASS2 ? 8 : 1); ++q)
#pragma unroll 1
        for (int q1 = 0; q1 < (PASS2 ? 1 : 8); ++q1) {
            const int sb = dir ? 7 - (q + q1) : (q + q1);
            bf16x8 uf;
            if (PASS2) uf = ufa[q]; else { const bf16* apq = ap; asm volatile("" : "+v"(apq)); uf = *(const bf16x8*)(apq + (size_t)(16 * sb) * PJ); }
            if (PASS2 && dir) uf = ufa[7 - q];
            f32x16 bu[2][2];
#pragma unroll
            for (int ph = 0; ph < 2; ++ph)
#pragma unroll
                for (int ri = 0; ri < 2; ++ri) bu[ph][ri] = MFMA32(uf, bfr[ph][ri], zero16);
#pragma unroll
            for (int rq = 0; rq < 16; ++rq) {
                const int r = dir ? 15 - rq : rq;
#pragma unroll
                for (int ph = 0; ph < 2; ++ph) {
                    const float nr = lr[ph] * sr[ph] - li[ph] * si[ph] + bu[ph][0][r], ni = lr[ph] * si[ph] + li[ph] * sr[ph] + bu[ph][1][r];
                    sr[ph] = nr; si[ph] = ni;
                    if (PASS2) *(LAS unsigned*)(wl + hl * S5_BATB + r * S5_ROWB + (j + 32 * ph) * 4) = pk2(nr, ni);
                }
            }
            if (PASS2) {
                asm volatile("s_waitcnt lgkmcnt(0)" ::: "memory");
#pragma unroll
                for (int bb = 0; bb < 2; ++bb)
#pragma unroll
                    for (int ks = 0; ks < 4; ++ks) {
                        const bf16x8 af = *(const LAS bf16x8*)(wl + bb * S5_BATB + (lane & 15) * S5_ROWB + (32 * ks + 8 * (lane >> 4)) * 2);
                        yacc[sb][bb] = MFMA16(af, cfr[ks], yacc[sb][bb]);
                    }
                asm volatile("s_waitcnt lgkmcnt(0)" ::: "memory");
            }
        }
        if (!PASS2) {
            float* e_ = E + ((size_t)((dir * 32 + g) * NCH + ch) * 2 + hl) * 128 + 2 * j;
#pragma unroll
            for (int ph = 0; ph < 2; ++ph) { e_[64 * ph] = sr[ph]; e_[64 * ph + 1] = si[ph]; }
        }
    }
    if (PASS2) {
        const int h = lane & 15, fq = lane >> 4;
        const float dv = a.in(19)[l * 512 + g * 16 + h];
        bf16* GA = (bf16*)(a.ws + WS_VT);
#pragma unroll
        for (int sb = 0; sb < 8; ++sb)
#pragma unroll
            for (int bb = 0; bb < 2; ++bb)
#pragma unroll
                for (int e = 0; e < 4; ++e) {
                    const int row = rb0 + bb * rbstep + 16 * sb + 4 * fq + e;
                    const float uu = bf2f(P[(size_t)row * PJ + COL_U + g * 16 + h]);
                    GA[(size_t)row * 512 + g * 16 + h] = (bf16)f2bf(gelu_tanh(yacc[sb][bb][e] + dv * uu));
                }
    }
}

constexpr float LOG2E = 1.4426950408889634f;
__device__ __forceinline__ void attn_task(const Ctx& a, int kind, int b, int h, int r, int jq, const LAS float* rpb  , int lane) {
    const int j = lane & 31, hl = lane >> 5;
    const bf16* P = (const bf16*)(a.ws + WS_A);
    const bf16* VT = (const bf16*)(a.ws + WS_VT) + (size_t)(b * 8 + h) * 64 * TOKP;
    bf16* YB = (bf16*)(a.ws + WS_Y3) + (size_t)R * 512;
    const int c = 32 * jq + j;
    const int rowq = kind == 0 ? b * SEQ + r * 64 + c : RL + b * CTXL + 32 * jq + j;
    bf16x8 qf[4];
#pragma unroll
    for (int s = 0; s < 4; ++s) qf[s] = *(const bf16x8*)(P + (size_t)rowq * PJ + COL_Q + h * 64 + 16 * s + 8 * hl);
    const int ka = j >> 3, kk = 16 * (ka >> 1) + 8 * ((j >> 2) & 1) + 4 * (ka & 1) + (j & 3);
    const f32x16 zero16 = {0.f, 0.f, 0.f, 0.f, 0.f, 0.f, 0.f, 0.f, 0.f, 0.f, 0.f, 0.f, 0.f, 0.f, 0.f, 0.f};
    f32x16 o0 = zero16, o1 = zero16;
    float m = -1e30f, lsum = 0.f;
    const int rs = min(max(r - 4, 0), 120), cs = min(max(c - 8, 0), 48);
    const float SC = 0.125f * LOG2E;
    const int ntile = kind == 0 ? 20 : 8;
#define ATT_TILE_LOAD(t_, KF, VF) do { int krow_, tok0_, tok1_; \
        if ((t_) < 8) { krow_ = RL + b * CTXL + 32 * (t_) + kk; tok0_ = SEQ + 32 * (t_) + 8 * hl; tok1_ = tok0_ + 16; } \
        else { const int w_ = (t_) - 8, jr2_ = w_ / 3, cb_ = jq + (w_ - 3 * jr2_), kr0_ = rs + 2 * jr2_, kc0_ = 16 * cb_; \
            krow_ = b * SEQ + (kr0_ + (kk >> 4)) * 64 + kc0_ + (kk & 15); tok0_ = kr0_ * 64 + kc0_ + 8 * hl; tok1_ = tok0_ + 64; } \
        const bf16* kp_ = P + (size_t)krow_ * PJ + COL_K + h * 64 + 8 * hl; \
        _Pragma("unroll") for (int s = 0; s < 4; ++s) KF[s] = *(const bf16x8*)(kp_ + 16 * s); \
        _Pragma("unroll") for (int dh = 0; dh < 2; ++dh) { VF[0][dh] = *(const bf16x8*)(VT + (size_t)(32 * dh + j) * TOKP + tok0_); VF[1][dh] = *(const bf16x8*)(VT + (size_t)(32 * dh + j) * TOKP + tok1_); } } while (0)
    bf16x8 kf[4], vf[2][2], kfn[4], vfn[2][2];
    ATT_TILE_LOAD(0, kf, vf);
    for (int t = 0; t < ntile; ++t) {
        { const int tn = t + 1 < ntile ? t + 1 : t; ATT_TILE_LOAD(tn, kfn, vfn); }
        int kr0 = 0, kc0 = 0;
        const bool win = t >= 8;
        if (win) { const int w = t - 8, jr2 = w / 3, cb = jq + (w - 3 * jr2); kr0 = rs + 2 * jr2; kc0 = 16 * cb; }
        f32x16 p = zero16;
#pragma unroll
        for (int s = 0; s < 4; ++s) p = MFMA32(kf[s], qf[s], p);
        float mx = -1e30f;
        if (!win) {
#pragma unroll
            for (int rr = 0; rr < 16; ++rr) { p[rr] *= SC; mx = fmaxf(mx, p[rr]); }
        } else {
            const LAS float* rp = rpb + h * 465;
#pragma unroll
            for (int rr = 0; rr < 16; ++rr) {
                const int kc = kc0 + 8 * hl + (rr & 7), kr = kr0 + (rr >> 3);
                const bool valid = (kc >= cs) && (kc < cs + 16);
                const int dc = min(max(kc - c + 15, 0), 30);
                const float bias = rp[(kr - r + 7) * 31 + dc];
                const float sv = valid ? p[rr] * SC + bias : -1e30f;
                p[rr] = sv; mx = fmaxf(mx, sv);
            }
        }
        mx = fmaxf(mx, __shfl_xor(mx, 32));
        const float mnew = fmaxf(m, mx), al = __builtin_amdgcn_exp2f(m - mnew);
        m = mnew;
        float ps = 0.f;
#pragma unroll
        for (int rr = 0; rr < 16; ++rr) { p[rr] = __builtin_amdgcn_exp2f(p[rr] - mnew); ps += p[rr]; }
        lsum = lsum * al + ps;
#pragma unroll
        for (int rr = 0; rr < 16; ++rr) { o0[rr] *= al; o1[rr] *= al; }
        bf16x8 pf[2];
#pragma unroll
        for (int sl = 0; sl < 2; ++sl) { v4u w; w.x = pk2(p[8 * sl], p[8 * sl + 1]); w.y = pk2(p[8 * sl + 2], p[8 * sl + 3]); w.z = pk2(p[8 * sl + 4], p[8 * sl + 5]); w.w = pk2(p[8 * sl + 6], p[8 * sl + 7]);
            pf[sl] = __builtin_bit_cast(bf16x8, w); }
#pragma unroll
        for (int sl = 0; sl < 2; ++sl) { o0 = MFMA32(vf[sl][0], pf[sl], o0); o1 = MFMA32(vf[sl][1], pf[sl], o1); }
#pragma unroll
        for (int s = 0; s < 4; ++s) kf[s] = kfn[s];
#pragma unroll
        for (int sl = 0; sl < 2; ++sl) { vf[sl][0] = vfn[sl][0]; vf[sl][1] = vfn[sl][1]; }
    }
#undef ATT_TILE_LOAD
    const float ltot = lsum + __shfl_xor(lsum, 32), inv = 1.0f / ltot;
    bf16* yp = YB + (size_t)rowq * 512 + h * 64 + 4 * hl;
#pragma unroll
    for (int gq = 0; gq < 4; ++gq) {
        v2u w0, w1;
        w0.x = pk2(o0[4 * gq] * inv, o0[4 * gq + 1] * inv); w0.y = pk2(o0[4 * gq + 2] * inv, o0[4 * gq + 3] * inv);
        w1.x = pk2(o1[4 * gq] * inv, o1[4 * gq + 1] * inv); w1.y = pk2(o1[4 * gq + 2] * inv, o1[4 * gq + 3] * inv);
        *(v2u*)(yp + 8 * gq) = w0; *(v2u*)(yp + 32 + 8 * gq) = w1;
    }
}

__device__ __forceinline__ void conv_item(const Ctx& a, int l, int item) {
    const int row = item >> 6, ch = (item & 63) * 8;
    const bf16* P = (const bf16*)(a.ws + WS_A);
    bf16* YC = (bf16*)(a.ws + WS_Y3) + (size_t)2 * R * 512;
    int t, T; if (row < RL) { t = row & 8191; T = SEQ; } else { t = (row - RL) & 255; T = CTXL; }
    const float* cw = a.in(22) + (size_t)l * 3 * 512 + ch;
    float y[8] = {0.f, 0.f, 0.f, 0.f, 0.f, 0.f, 0.f, 0.f};
#pragma unroll
    for (int i = 0; i < 3; ++i) {
        const int tt = t + i - 1; if (tt < 0 || tt >= T) continue;
        const bf16* rp = P + (size_t)(row + i - 1) * PJ + ch;
        const v4u z = *(const v4u*)(rp + COL_Z), cg_ = *(const v4u*)(rp + COL_C);
        const f32x4 w0 = *(const f32x4*)(cw + i * 512), w1 = *(const f32x4*)(cw + i * 512 + 4);
        y[0] += w0[0] * bflo(z.x) * bflo(cg_.x); y[1] += w0[1] * bfhi(z.x) * bfhi(cg_.x); y[2] += w0[2] * bflo(z.y) * bflo(cg_.y); y[3] += w0[3] * bfhi(z.y) * bfhi(cg_.y);
        y[4] += w1[0] * bflo(z.z) * bflo(cg_.z); y[5] += w1[1] * bfhi(z.z) * bfhi(cg_.z); y[6] += w1[2] * bflo(z.w) * bflo(cg_.w); y[7] += w1[3] * bfhi(z.w) * bfhi(cg_.w);
    }
    const v4u bg = *(const v4u*)(P + (size_t)row * PJ + COL_B + ch);
    v4u w; w.x = pk2(y[0] * bflo(bg.x), y[1] * bfhi(bg.x)); w.y = pk2(y[2] * bflo(bg.y), y[3] * bfhi(bg.y)); w.z = pk2(y[4] * bflo(bg.z), y[5] * bfhi(bg.z)); w.w = pk2(y[6] * bflo(bg.w), y[7] * bfhi(bg.w));
    *(v4u*)(YC + (size_t)row * 512 + ch) = w;
}

typedef GAS unsigned gu32;
#define XB_TMO      128
#define XB_XCNT(j)  (256  + 64 * (j))
#define XB_XSUB(j)  (1280 + 64 * (j))
#define XB_XGEN(j)  (2304 + 64 * (j))
#define XB_TOP      3328
#define XB_TOPGEN   3392
#define XCD_BAR_WORDS 3456
#define XB_SPIN_CAP (1u << 18)

__device__ __forceinline__ unsigned xb_ld(unsigned* p)              { return __hip_atomic_load(p, __ATOMIC_RELAXED, __HIP_MEMORY_SCOPE_AGENT); }
__device__ __forceinline__ unsigned xb_add(unsigned* p, unsigned v) { return __hip_atomic_fetch_add(p, v, __ATOMIC_RELAXED, __HIP_MEMORY_SCOPE_AGENT); }
__device__ __forceinline__ unsigned xb_xcc_id() { return (unsigned)__builtin_amdgcn_s_getreg((3 << 11) | 20) & 0xFu; }
#define XB_SPIN(cond, bar) do { unsigned _sp = 0; while (cond) { __builtin_amdgcn_s_sleep(1); \
    if ((++_sp & 255u) == 0u) { if (xb_ld(&(bar)[XB_TMO])) break; if (_sp > XB_SPIN_CAP) { atomicAdd(&(bar)[XB_TMO], 1u); break; } } } } while (0)

struct XcdBarrier {
    unsigned* bar; unsigned x;
    volatile LAS unsigned* st;
};

__device__ __forceinline__ XcdBarrier xcd_barrier_post(unsigned* bar, volatile LAS unsigned* st) {
    XcdBarrier b; b.bar = bar; b.x = xb_xcc_id(); b.st = st;
    if (threadIdx.x == 0) (void)xb_add(&bar[XB_XCNT(b.x)], 1u);
    return b;
}
__device__ __forceinline__ void xcd_barrier_complete(unsigned* bar, unsigned x, unsigned& nloc, unsigned& nx) {
    const unsigned G = gridDim.x * gridDim.y * gridDim.z;
    unsigned sum, cnt, mine, sp = 0u;
    for (;;) {
        sum = 0u; cnt = 0u; mine = 0u;
#pragma unroll
        for (unsigned j = 0; j < 16; ++j) { const unsigned c = xb_ld(&bar[XB_XCNT(j)]); sum += c; cnt += (c > 0u) ? 1u : 0u; mine = (j == x) ? c : mine; }
        if (sum == G) break;
        __builtin_amdgcn_s_sleep(1);
        if ((++sp & 255u) == 0u) { if (xb_ld(&bar[XB_TMO])) break; if (sp > XB_SPIN_CAP) { atomicAdd(&bar[XB_TMO], 1u); break; } }
    }
    nloc = mine > 0u ? mine : 1u; nx = cnt > 0u ? cnt : 1u;
}

__device__ __forceinline__ void xcd_barrier(const XcdBarrier& b) {
    asm volatile("s_waitcnt vmcnt(0)" ::: "memory");
    __syncthreads();
    if (threadIdx.x == 0) {
        unsigned* bar = b.bar;
        __builtin_amdgcn_s_waitcnt(0);
        unsigned nloc = b.st[0], nx = b.st[1];
        if (nloc == 0u) { xcd_barrier_complete(bar, b.x, nloc, nx); b.st[0] = nloc; b.st[1] = nx; }
        const unsigned old = xb_add(&bar[XB_XSUB(b.x)], 1u);
        const unsigned gen = old / nloc;
        if (old + 1u == (gen + 1u) * nloc) {
            __builtin_amdgcn_fence(__ATOMIC_RELEASE, "agent");
            asm volatile("s_waitcnt vmcnt(0)" ::: "memory");
            const unsigned og = xb_add(&bar[XB_TOP], 1u);
            const unsigned tg = og / nx;
            if (og + 1u == (tg + 1u) * nx) xb_add(&bar[XB_TOPGEN], 1u);
            else XB_SPIN(xb_ld(&bar[XB_TOPGEN]) == tg, bar);
            __builtin_amdgcn_fence(__ATOMIC_ACQUIRE, "agent");
            xb_add(&bar[XB_XGEN(b.x)], 1u);
            asm volatile("s_waitcnt vmcnt(0)" ::: "memory");
        } else {
            XB_SPIN(xb_ld(&bar[XB_XGEN(b.x)]) == gen, bar);
            __builtin_amdgcn_fence(__ATOMIC_ACQUIRE, "agent");
            asm volatile("s_waitcnt vmcnt(0)" ::: "memory");
        }
    }
    __syncthreads();
}

template <class Epi, class Sched>
__device__ __forceinline__ void run_gemm(LAS unsigned char* lds, const bf16* A, const bf16* Bt, int M, int N, int K, const Sched& S, const Epi& E) {
    pg8::Gemm g{A, Bt, M, N, K, K};
    pg8::gemm_phase<Epi, Sched, true, true>(lds, g, S, E);
}
template <class Epi, class Sched>
__device__ __forceinline__ void run_gemm_chunk(LAS unsigned char* lds, const bf16* A, const bf16* Bt, int M, int N, int Kc, int ld, const Sched& S, const Epi& E) {
    pg8::Gemm g{A, Bt, M, N, Kc, ld};
    pg8::gemm_phase<Epi, Sched, true, true>(lds, g, S, E);
}

__global__ void __launch_bounds__(NWAVES * 64, 2) fwd_megakernel(Args a) {
    extern __shared__ __attribute__((aligned(16))) unsigned char lds_raw[];
    LAS unsigned char* lds = (LAS unsigned char*)lds_raw;
    LAS float* misc = (LAS float*)(lds + 131072);
    cg::grid_group grid = cg::this_grid();
    int tid = threadIdx.x, lane = tid & 63; int wave = __builtin_amdgcn_readfirstlane(tid >> 6);
    int G = gridDim.x, bx = blockIdx.x;
    int gw = bx * NWAVES + wave, NGW = G * NWAVES, NGT = G * NWAVES * 64; int gt = bx * (NWAVES * 64) + tid;
    Ctx c; c.ws = a.ws;
    volatile LAS unsigned* xst = (volatile LAS unsigned*)(lds + 131072 + 16128);
    if (tid < 2) xst[tid] = 0u;
    __syncthreads();
    (void)xcd_barrier_post((unsigned*)(a.ws + WS_BAR), xst);
#define PHASE_OPAQUE() do { tid = threadIdx.x; asm volatile("" : "+v"(tid)); lane = tid & 63; { int b_ = blockIdx.x, g_ = gridDim.x; asm volatile("" : "+v"(b_), "+v"(g_)); bx = __builtin_amdgcn_readfirstlane(b_); G = __builtin_amdgcn_readfirstlane(g_); } \
        NGW = G * NWAVES; NGT = G * NWAVES * 64; gt = bx * (NWAVES * 64) + tid; wave = __builtin_amdgcn_readfirstlane(tid >> 6); gw = bx * NWAVES + wave; \
        unsigned lo_ = (unsigned)(uintptr_t)a.ws, hi_ = (unsigned)((uintptr_t)a.ws >> 32); asm volatile("" : "+v"(lo_), "+v"(hi_)); \
        lo_ = __builtin_amdgcn_readfirstlane(lo_); hi_ = __builtin_amdgcn_readfirstlane(hi_); c.ws = (unsigned char*)(((uintptr_t)hi_ << 32) | (uintptr_t)lo_); } while (0)
#define SYNC() do { XcdBarrier b_; b_.bar = (unsigned*)(c.ws + WS_BAR); b_.x = xb_xcc_id(); b_.st = (volatile LAS unsigned*)(lds + 131072 + 16128); xcd_barrier(b_); PHASE_OPAQUE(); } while (0)
#define SYNC_CG() do { asm volatile("s_waitcnt vmcnt(0)" ::: "memory"); __syncthreads(); \
        if (wave == 0) { __builtin_amdgcn_fence(__ATOMIC_RELEASE, "agent"); asm volatile("s_waitcnt vmcnt(0)" ::: "memory"); } \
        grid.sync(); \
        __builtin_amdgcn_fence(__ATOMIC_ACQUIRE, "agent"); asm volatile("s_waitcnt vmcnt(0)" ::: "memory"); __syncthreads(); \
        PHASE_OPAQUE(); } while (0)
#define WSP(T, off) ((T*)(c.ws + (off)))
#ifndef DBG_STOP
#define DBG_STOP -1
#endif
#define DBG(k, off, nelem) do { if (DBG_STOP == (k)) { if ((nelem) > 0) { const bf16* s_ = WSP(bf16, off); float* o_ = c.out(); \
        for (size_t i_ = (size_t)gt; i_ < (size_t)RL * D; i_ += (size_t)NGT) o_[i_] = bf2f(s_[i_ % (size_t)(nelem)]); } return; } } while (0)
#define XROW(row) ((row) < RL ? c.out() + (size_t)(row) * D : WSP(float, WS_XC) + (size_t)((row) - RL) * D)

    if (tid < 26) ((const float**)(a.ws + WS_PTRS))[tid] = tid < 25 ? a.in[tid] : (const float*)a.out;
    for (int i = tid; i < 3 * D; i += NWAVES * 64) { const int mid = i >> 10, k = i & 1023; const float cv = mid < 2 ? a.in[1][mid * D + k] : a.in[3][k]; misc[i] = cv / (1.0f + expf(-cv)); }
    __syncthreads();
    {
        float* modv = (float*)(a.ws + WS_MODV);
        for (int idx = gt; idx < 2 * 16 * NMODV; idx += NGT) {
            const int n = idx % NMODV, kc = (idx / NMODV) & 15, l = idx / (NMODV * 16);
            const float* w = a.in[4] + ((size_t)l * D + 64 * kc) * NMODV + n;
            float a0 = 0.f, a1 = 0.f, a2 = 0.f;
#pragma unroll 8
            for (int k = 0; k < 64; ++k) { const float wv = w[(size_t)k * NMODV]; a0 += misc[64 * kc + k] * wv; a1 += misc[D + 64 * kc + k] * wv; a2 += misc[2 * D + 64 * kc + k] * wv; }
            if (kc == 0) { const float bm = a.in[5][l * NMODV + n]; a0 += bm; a1 += bm; a2 += bm; }
            atomicAdd(modv + (size_t)(l * 3 + 0) * NMODV + n, a0); atomicAdd(modv + (size_t)(l * 3 + 1) * NMODV + n, a1); atomicAdd(modv + (size_t)(l * 3 + 2) * NMODV + n, a2);
        }
    }
    if (gt < 8192) s5_tables(a, gt);
    __syncthreads();
    {
        LAS float* scr = (LAS float*)(lds + wave * 16384);
        for (int it = gw; it < 2 * IT_LAYER; it += NGW) convert_item(a, it, scr, lane);
    }
    if (G > (1 << 20)) SYNC_CG();
    SYNC();
    for (int row = gw; row < R; row += NGW) {
        const float* xrow = row < RL ? c.in(0) + (size_t)row * D : c.in(2) + (size_t)(row - RL) * D;
        const float* mv = WSP(float, WS_MODV) + (size_t)mid_of_row(row) * NMODV;
        mod_row(xrow, mv, mv + D, WSP(bf16, WS_H) + (size_t)row * D, lane);
        if (row >= RL) { const f32x4* xr = (const f32x4*)xrow + lane; f32x4* xo = (f32x4*)(WSP(float, WS_XC) + (size_t)(row - RL) * D) + lane;
#pragma unroll
            for (int j = 0; j < 4; ++j) xo[64 * j] = xr[64 * j] * ALPHA; }
    }
    SYNC();

    DBG(1, WS_H, (size_t)R * D);
    DBG(2, WS_W, (size_t)WL_BYTES / 2);
#pragma unroll 1
    for (int l = 0; l < 2; ++l) {
#define WL(off) ((const bf16*)(c.ws + WS_W + (size_t)l * WL_BYTES + (off)))
#define MVL (WSP(float, WS_MODV) + (size_t)l * 3 * NMODV)
        pg8::StaticOrder SO;
        const int RM = l == 0 ? R : RL;
        { SO.init(R, NUP, G, bx); EpiSwiglu E{WSP(bf16, WS_A)}; run_gemm(lds, WSP(bf16, WS_H), WL(WO_UP0), R, NUP, D, SO, E); }
        SYNC();
        DBG(10 + 100 * l, WS_A, (size_t)R * FF);
        { SO.init(RL, D, G, bx); float* XL = c.out(); float* XC = WSP(float, WS_XC);
          EpiRes E{l == 0 ? c.in(0) : XL, XC, XL, XC, MVL + 2 * D, 0.5f}; run_gemm(lds, WSP(bf16, WS_A), WL(WO_DN0), RL, D, FF, SO, E); }
        { PHASE_OPAQUE(); CtxChunkOrder CO{G, bx, FF / 256}; EpiResSlab E{WSP(float, WS_SLAB), MVL + 2 * NMODV + 2 * D, 0.5f}; run_gemm_chunk(lds, WSP(bf16, WS_A), WL(WO_DN0), R, D, 256, FF, CO, E); }
        SYNC();
        DBG(11 + 100 * l, 0, 0);
        for (int row = gw; row < R; row += NGW) {
            const float* mv = MVL + (size_t)mid_of_row(row) * NMODV;
            ln_row(XROW(row), c.in(6) + (size_t)l * 3 * D, c.in(7) + (size_t)l * 3 * D, mv + 3 * D, mv + 4 * D, WSP(bf16, WS_H) + (size_t)row * D, lane, row < RL ? 1.0f : ALPHA, WSP(float, WS_SLAB) + (size_t)(row - RL) * D, row < RL ? 0 : FF / 256);
        }
        SYNC();
        DBG(12 + 100 * l, WS_H, (size_t)R * D);
        { SO.init(R, PJ, G, bx); EpiProj E{WSP(bf16, WS_A), WSP(bf16, WS_VT)}; run_gemm(lds, WSP(bf16, WS_H), WL(WO_IN), R, PJ, D, SO, E); }
        SYNC();
        DBG(13 + 100 * l, WS_A, (size_t)R * PJ);
       DBG(14 + 100 * l, WS_VT, (size_t)R * 512);
        {
            const float* rpb = c.in(21) + (size_t)l * 8 * 465;
            for (int i = tid; i < 8 * 465; i += NWAVES * 64) misc[i] = rpb[i] * LOG2E;
            __syncthreads();
            const int natt = 4096 + (l == 0 ? 128 : 0);
            for (int u = gw; u < natt; u += NGW) {
                if (u < 4096) attn_task(c, 0, u >> 11, (u >> 8) & 7, (u >> 1) & 127, u & 1, misc, lane);
                else { const int v = u - 4096; attn_task(c, 1, v >> 6, (v >> 3) & 7, 0, v & 7, misc, lane); }
            }
            for (int t = NGW - 1 - gw; t < 32 * NCH; t += NGW) s5_task<false>(c, l, t / NCH, t % NCH, lds + wave * S5_WAVEB, lane);
            for (int item = gt; item < R * 64; item += NGT) conv_item(c, l, item);
        }
        SYNC();
        DBG(15 + 100 * l, WS_Y3 + (size_t)R * 512 * 2, (size_t)2 * R * 512);
        {
            for (int t = gw; t < 32 * NCH; t += NGW) s5_task<true>(c, l, t / NCH, t % NCH, lds + wave * S5_WAVEB, lane);
            asm volatile("s_waitcnt vmcnt(0) lgkmcnt(0)" ::: "memory");
            __syncthreads();
            PHASE_OPAQUE();
            SO.init(RM, NGATE, G, bx); EpiGates E{WSP(bf16, WS_A)}; run_gemm(lds, WSP(bf16, WS_H), WL(WO_IN) + (size_t)PJ * D, RM, NGATE, D, SO, E);
        }
        SYNC();
        DBG(16 + 100 * l, WS_VT, (size_t)R * 512);
        DBG(17 + 100 * l, WS_A, (size_t)R * PJ);
        { SO.init(RM, 512, G, bx); EpiGlu E{WSP(bf16, WS_VT), WSP(bf16, WS_Y3)}; run_gemm(lds, WSP(bf16, WS_VT), WL(WO_G), RM, 512, 512, SO, E); }
        SYNC();
        DBG(18 + 100 * l, WS_Y3, (size_t)R * 512);
        { BranchOrder BO{G, bx, RM / 64}; EpiBranch E{WSP(bf16, WS_A), WSP(bf16, WS_H)}; run_gemm(lds, WSP(bf16, WS_Y3), WL(WO_G) + (size_t)512 * 512, 3 * R, 3072, 512, BO, E); }
        SYNC();
        DBG(19 + 100 * l, WS_H, (size_t)R * D);
        { SO.init(RL, D, G, bx); float* XL = c.out(); float* XC = WSP(float, WS_XC); EpiRes E{XL, XC, XL, XC, MVL + 5 * D, 1.0f}; run_gemm(lds, WSP(bf16, WS_H), WL(WO_OUT), RL, D, D, SO, E); }
        if (l == 0) { PHASE_OPAQUE(); CtxChunkOrder CO{G, bx, D / 256}; EpiResSlab E{WSP(float, WS_SLAB), MVL + 2 * NMODV + 5 * D, 1.0f}; run_gemm_chunk(lds, WSP(bf16, WS_H), WL(WO_OUT), R, D, 256, D, CO, E); }
        SYNC();
        DBG(20 + 100 * l, 0, 0);
        for (int row = gw; row < RM; row += NGW) {
            const float* mv = MVL + (size_t)mid_of_row(row) * NMODV;
            ln_row(XROW(row), c.in(6) + (size_t)(l * 3 + 1) * D, c.in(7) + (size_t)(l * 3 + 1) * D, mv + 6 * D, mv + 7 * D, WSP(bf16, WS_H) + (size_t)row * D, lane, row < RL ? 1.0f : ALPHA, WSP(float, WS_SLAB) + (size_t)(row - RL) * D, row < RL ? 0 : D / 256);
        }
        SYNC();
        DBG(21 + 100 * l, 0, 0);
        { SO.init(RM, NUP, G, bx); EpiSwiglu E{WSP(bf16, WS_A)}; run_gemm(lds, WSP(bf16, WS_H), WL(WO_UP1), RM, NUP, D, SO, E); }
        SYNC();
        { SO.init(RL, D, G, bx); float* XL = c.out(); float* XC = WSP(float, WS_XC); EpiRes E{XL, XC, XL, XC, MVL + 8 * D, 0.5f}; run_gemm(lds, WSP(bf16, WS_A), WL(WO_DN1), RL, D, FF, SO, E); }
        if (l == 0) { PHASE_OPAQUE(); CtxChunkOrder CO{G, bx, FF / 256}; EpiResSlab E{WSP(float, WS_SLAB), MVL + 2 * NMODV + 8 * D, 0.5f}; run_gemm_chunk(lds, WSP(bf16, WS_A), WL(WO_DN1), R, D, 256, FF, CO, E); }
        SYNC();
        for (int row = gw; row < RM; row += NGW) {
            const float* mv = MVL + 3 * NMODV + (size_t)mid_of_row(row) * NMODV;
            ln_row(XROW(row), c.in(6) + (size_t)(l * 3 + 2) * D, c.in(7) + (size_t)(l * 3 + 2) * D, mv, mv + D, l == 0 ? WSP(bf16, WS_H) + (size_t)row * D : (bf16*)nullptr, lane, row < RL ? 1.0f : ALPHA, WSP(float, WS_SLAB) + (size_t)(row - RL) * D, row < RL ? 0 : FF / 256);
        }
        if (l == 0) SYNC();
    }
}

extern "C" void kernel_launch(void* const* d_in, const int* in_sizes, int n_in, void* d_out, int out_size, void* d_ws, size_t ws_size, hipStream_t stream) {
    static int grid = 0;
    if (grid == 0) {
        if (n_in != 25 || in_sizes[0] != RL * D || out_size != RL * D || ws_size < WS_END) {
            fprintf(stderr, "kernel_launch: unexpected shapes (n_in %d, in0 %d, out %d, ws %zu, need %zu); nothing launched\n", n_in, n_in > 0 ? in_sizes[0] : -1, out_size, ws_size, (size_t)WS_END); grid = -1; return; }
        int dev = 0, cus = 0, per_cu = 0;
        if (hipGetDevice(&dev) != hipSuccess || hipDeviceGetAttribute(&cus, hipDeviceAttributeMultiprocessorCount, dev) != hipSuccess) { grid = -1; return; }
        if (hipFuncSetAttribute((const void*)fwd_megakernel, hipFuncAttributeMaxDynamicSharedMemorySize, LDS_BYTES) != hipSuccess) { fprintf(stderr, "kernel_launch: hipFuncSetAttribute failed\n"); grid = -1; return; }
        if (hipOccupancyMaxActiveBlocksPerMultiprocessor(&per_cu, (const void*)fwd_megakernel, NWAVES * 64, LDS_BYTES) != hipSuccess || per_cu < 1) { fprintf(stderr, "kernel_launch: occupancy query says %d\n", per_cu); grid = -1; return; }
        grid = cus;
    }
    if (grid < 0) return;
    (void)hipMemsetAsync((char*)d_ws + WS_MODV, 0, MODV_ZERO_BYTES, stream);
    Args a{};
    for (int i = 0; i < 25; ++i) a.in[i] = (const float*)d_in[i];
    a.out = (float*)d_out; a.ws = (unsigned char*)d_ws;
    void* args[] = {&a};
    const hipError_t e = hipLaunchCooperativeKernel((const void*)fwd_megakernel, dim3(grid), dim3(NWAVES * 64), args, LDS_BYTES, stream);
    if (e != hipSuccess) fprintf(stderr, "kernel_launch: cooperative launch failed: %s (grid %d)\n", hipGetErrorString(e), grid);
}
```
